# Optimizing an MI355X kernel written in HIP

```python
import math
import jax, jax.numpy as jnp
from jax import lax
import numpy as np


D_MODEL = 1024
BATCH = 8
SEQ = 2048
DEPTH = 2
DEC_BATCH = 128
DEC_SEQ = 8
PAST_LEN = 16384
PAGE_SIZE = 128

N_MIXERS = 2
N_A = (DEPTH + 1) // 2
N_B = DEPTH // 2
A_WIDTH = 2 * D_MODEL
A_CONV = 3
B_WIDTH = 2 * D_MODEL
B_CONV = 4
B_HEADS = 4
B_DK = B_WIDTH // B_HEADS
B_DV = B_WIDTH // B_HEADS
B_CHUNK = 64
RMS_EPS = 1e-6
LN_EPS = 1e-5

kernel_name = "hybrid_shortconv_mlstm_step"


def rmsnorm(x, w):
    xf = x.astype(jnp.float32)
    y = xf * lax.rsqrt(jnp.mean(xf * xf, axis=-1, keepdims=True) + RMS_EPS)
    return (y * w.astype(jnp.float32)).astype(x.dtype)


def causal_dwconv(u, buf, w):
    K = w.shape[0]
    T = u.shape[1]
    full = jnp.concatenate([buf.astype(u.dtype), u], axis=1)
    out = full[:, 0:T] * w[0]
    for j in range(1, K):
        out = out + full[:, j:j + T] * w[j]
    return out, full[:, full.shape[1] - (K - 1):]


def short_conv_mixer(h, buf, w_in, conv_w, w_out):
    b_gate, c_gate, xa, z = jnp.split(h @ w_in, 4, axis=-1)
    u = c_gate * xa
    conv, new_buf = causal_dwconv(u, buf, conv_w)
    y = b_gate * conv * jax.nn.silu(z)
    return y @ w_out, new_buf


def mlstm_chunkwise(q, k, v, ig, logf, C0, n0, m0):
    bsz, nh, t, _ = q.shape
    dv = v.shape[-1]
    L = math.gcd(t, B_CHUNK)
    nc = t // L

    def to_chunks(a):
        a = a.reshape((bsz, nh, nc, L) + a.shape[3:])
        return jnp.moveaxis(a, 2, 0)

    causal = jnp.tril(jnp.ones((L, L), dtype=bool))

    def step(carry, inp):
        C, n, m = carry
        qj, kj, vj, ij, fj = inp
        b = jnp.cumsum(fj, axis=-1)
        g = b[..., -1]
        logD = jnp.where(causal, b[..., :, None] - b[..., None, :] + ij[..., None, :], -jnp.inf)
        inter = b + m[..., None]
        m_row = jnp.maximum(inter, jnp.max(logD, axis=-1))
        w_inter = jnp.exp(inter - m_row)
        S = jnp.einsum('bhid,bhjd->bhij', qj, kj) * jnp.exp(logD - m_row[..., None])
        num = w_inter[..., None] * jnp.einsum('bhid,bhde->bhie', qj, C) + jnp.einsum('bhij,bhje->bhie', S, vj)
        den = w_inter * jnp.einsum('bhid,bhd->bhi', qj, n) + jnp.sum(S, axis=-1)
        h = num / jnp.maximum(jnp.abs(den), jnp.exp(-m_row))[..., None]
        logw = g[..., None] - b + ij
        m_new = jnp.maximum(g + m, jnp.max(logw, axis=-1))
        decay = jnp.exp(g + m - m_new)
        kw = kj * jnp.exp(logw - m_new[..., None])[..., None]
        C_new = decay[..., None, None] * C + jnp.einsum('bhjd,bhje->bhde', kw, vj)
        n_new = decay[..., None] * n + jnp.sum(kw, axis=2)
        return (C_new, n_new, m_new), h

    xs = (to_chunks(q), to_chunks(k), to_chunks(v), to_chunks(ig), to_chunks(logf))
    (C, n, m), hs = lax.scan(step, (C0, n0, m0), xs)
    hs = jnp.moveaxis(hs, 0, 2).reshape(bsz, nh, t, dv)
    return hs, C, n, m


def mlstm_mixer(h, conv_buf, C0, n0, m0, w_in, conv_w, conv_b, w_q, w_k, w_v, w_if, b_if, skip, onorm_w, w_out):
    bsz, t, _ = h.shape
    f32 = jnp.float32
    xm, z = jnp.split(h @ w_in, 2, axis=-1)
    xc, new_buf = causal_dwconv(xm, conv_buf, conv_w)
    xc = jax.nn.silu(xc + conv_b)
    q = xc @ w_q
    k = xc @ w_k
    v = xm @ w_v
    gates = (jnp.concatenate([q, k, v], axis=-1) @ w_if + b_if).astype(f32)
    ig = gates[..., :B_HEADS].transpose(0, 2, 1)
    logf = jax.nn.log_sigmoid(gates[..., B_HEADS:]).transpose(0, 2, 1)

    def heads(a, d):
        return a.reshape(bsz, t, B_HEADS, d).transpose(0, 2, 1, 3).astype(f32)

    hh, C, n, m = mlstm_chunkwise(heads(q, B_DK), heads(k, B_DK) * (B_DK ** -0.5), heads(v, B_DV),
                                  ig, logf, C0.astype(f32), n0.astype(f32), m0.astype(f32))
    mu = jnp.mean(hh, axis=-1, keepdims=True)
    var = jnp.mean(jnp.square(hh - mu), axis=-1, keepdims=True)
    hn = ((hh - mu) * lax.rsqrt(var + LN_EPS)).transpose(0, 2, 1, 3).reshape(bsz, t, B_WIDTH)
    out = ((hn * onorm_w.astype(f32)).astype(h.dtype) + skip * xc) * jax.nn.silu(z)
    return out @ w_out, new_buf, C, n, m


def run_trunk(x, conv_a, conv_b, C, n, m, norm_w, final_norm_w, a_w_in, a_conv_w, a_w_out,
              b_w_in, b_conv_w, b_conv_b, b_w_q, b_w_k, b_w_v, b_w_if, b_b_if, b_skip, b_onorm_w, b_w_out):
    new_a, new_b, new_C, new_n, new_m = [], [], [], [], []
    for layer in range(DEPTH):
        hnorm = rmsnorm(x, norm_w[layer])
        j = layer // N_MIXERS
        if layer % N_MIXERS == 0:
            out, buf = short_conv_mixer(hnorm, conv_a[j], a_w_in[j], a_conv_w[j], a_w_out[j])
            new_a.append(buf)
        else:
            out, buf, Cj, nj, mj = mlstm_mixer(hnorm, conv_b[j], C[j], n[j], m[j], b_w_in[j], b_conv_w[j],
                                               b_conv_b[j], b_w_q[j], b_w_k[j], b_w_v[j], b_w_if[j], b_b_if[j],
                                               b_skip[j], b_onorm_w[j], b_w_out[j])
            new_b.append(buf)
            new_C.append(Cj)
            new_n.append(nj)
            new_m.append(mj)
        x = x + out
    y = rmsnorm(x, final_norm_w)
    return y, jnp.stack(new_a), jnp.stack(new_b), jnp.stack(new_C), jnp.stack(new_n), jnp.stack(new_m)


def setup_inputs(seed: int = 0) -> dict:
    key = jax.random.key(seed)
    ks = jax.random.split(key, 24)
    f32 = jnp.float32

    def nrm(k, shape, scale):
        return jax.random.normal(k, shape, f32) * scale

    ig_bias = nrm(ks[19], (N_B, B_HEADS), 0.1)
    fg_bias = jnp.linspace(3.0, 6.0, B_HEADS, dtype=f32)[None, :] + nrm(ks[20], (N_B, B_HEADS), 0.01)
    return {
        'x_prompt': nrm(ks[0], (BATCH, SEQ, D_MODEL), 1.0),
        'x_sample': nrm(ks[1], (DEC_BATCH, DEC_SEQ, D_MODEL), 1.0),
        'state_conv_a': nrm(ks[2], (N_A, DEC_BATCH, A_CONV - 1, A_WIDTH), 1.0),
        'state_conv_b': nrm(ks[3], (N_B, DEC_BATCH, B_CONV - 1, B_WIDTH), 1.0),
        'state_C': nrm(ks[4], (N_B, DEC_BATCH, B_HEADS, B_DK, B_DV), B_DK ** -0.5),
        'state_n': nrm(ks[5], (N_B, DEC_BATCH, B_HEADS, B_DK), B_DK ** -0.5),
        'state_m': nrm(ks[6], (N_B, DEC_BATCH, B_HEADS), 1.0),
        'norm_w': 1.0 + nrm(ks[7], (DEPTH, D_MODEL), 0.02),
        'final_norm_w': 1.0 + nrm(ks[8], (D_MODEL,), 0.02),
        'a_w_in': nrm(ks[9], (N_A, D_MODEL, 4 * A_WIDTH), D_MODEL ** -0.5),
        'a_conv_w': nrm(ks[10], (N_A, A_CONV, A_WIDTH), A_CONV ** -0.5),
        'a_w_out': nrm(ks[11], (N_A, A_WIDTH, D_MODEL), A_WIDTH ** -0.5),
        'b_w_in': nrm(ks[12], (N_B, D_MODEL, 2 * B_WIDTH), D_MODEL ** -0.5),
        'b_conv_w': nrm(ks[13], (N_B, B_CONV, B_WIDTH), B_CONV ** -0.5),
        'b_conv_b': nrm(ks[14], (N_B, B_WIDTH), 0.02),
        'b_w_q': nrm(ks[15], (N_B, B_WIDTH, B_HEADS * B_DK), B_WIDTH ** -0.5),
        'b_w_k': nrm(ks[16], (N_B, B_WIDTH, B_HEADS * B_DK), B_WIDTH ** -0.5),
        'b_w_v': nrm(ks[17], (N_B, B_WIDTH, B_HEADS * B_DV), B_WIDTH ** -0.5),
        'b_w_if': nrm(ks[18], (N_B, 3 * B_WIDTH, 2 * B_HEADS), (3 * B_WIDTH) ** -0.5),
        'b_b_if': jnp.concatenate([ig_bias, fg_bias], axis=-1),
        'b_skip': 1.0 + nrm(ks[21], (N_B, B_WIDTH), 0.02),
        'b_onorm_w': 1.0 + nrm(ks[22], (N_B, B_WIDTH), 0.02),
        'b_w_out': nrm(ks[23], (N_B, B_WIDTH, D_MODEL), B_WIDTH ** -0.5),
    }


def reference(x_prompt, x_sample, state_conv_a, state_conv_b, state_C, state_n, state_m,
              norm_w, final_norm_w, a_w_in, a_conv_w, a_w_out,
              b_w_in, b_conv_w, b_conv_b, b_w_q, b_w_k, b_w_v, b_w_if, b_b_if, b_skip, b_onorm_w, b_w_out):
    f32 = jnp.float32
    pb = x_prompt.shape[0]
    zc_a = jnp.zeros((N_A, pb, A_CONV - 1, A_WIDTH), x_prompt.dtype)
    zc_b = jnp.zeros((N_B, pb, B_CONV - 1, B_WIDTH), x_prompt.dtype)
    zC = jnp.zeros((N_B, pb, B_HEADS, B_DK, B_DV), f32)
    zn = jnp.zeros((N_B, pb, B_HEADS, B_DK), f32)
    zm = jnp.zeros((N_B, pb, B_HEADS), f32)
    y_prompt, ca_p, cb_p, C_p, n_p, m_p = run_trunk(
        x_prompt, zc_a, zc_b, zC, zn, zm, norm_w, final_norm_w, a_w_in, a_conv_w, a_w_out,
        b_w_in, b_conv_w, b_conv_b, b_w_q, b_w_k, b_w_v, b_w_if, b_b_if, b_skip, b_onorm_w, b_w_out)
    y_sample, ca_s, cb_s, C_s, n_s, m_s = run_trunk(
        x_sample, state_conv_a, state_conv_b, state_C, state_n, state_m, norm_w, final_norm_w,
        a_w_in, a_conv_w, a_w_out, b_w_in, b_conv_w, b_conv_b, b_w_q, b_w_k, b_w_v, b_w_if, b_b_if,
        b_skip, b_onorm_w, b_w_out)
    return (y_prompt, y_sample, ca_p, ca_s, cb_p, cb_s, C_p, C_s, n_p, n_s, m_p, m_s)
```

```cpp
#include <hip/hip_runtime.h>
#include <hip/hip_cooperative_groups.h>
#include <cstdio>
#include <cstdint>
namespace cg = cooperative_groups;

#define DI __device__ __forceinline__
#define LAS __attribute__((address_space(3)))
typedef unsigned short bf16_t;
typedef short bf16x8 __attribute__((ext_vector_type(8)));
typedef float f32x4 __attribute__((ext_vector_type(4)));
typedef unsigned u32x4 __attribute__((ext_vector_type(4)));
typedef unsigned u32x2 __attribute__((ext_vector_type(2)));

constexpr int DM = 1024, WD = 2048, TP = 16384, TSM = 1024, TT = TP + TSM;
constexpr int NHD = 4, DKH = 512;
constexpr float QK_SCALE = 0.04419417382415922f;
constexpr size_t O_Y = 0, O_CAP = 17825792, O_CAS = 17858560, O_CBP = 18382848, O_CBS = 18432000, O_CP = 19218432, O_CS = 27607040,
                 O_NP = 161824768, O_NS = 161841152, O_MP = 162103296, O_MS = 162103328;
constexpr size_t SZ_A1 = (size_t)TT * DM * 2, SZ_A2 = (size_t)TT * WD * 2;
constexpr size_t WS_WAIN = 0;
constexpr size_t WS_WAOUT = WS_WAIN + (size_t)8192 * 1024 * 2;
constexpr size_t WS_WBIN = WS_WAOUT + (size_t)1024 * 2048 * 2;
constexpr size_t WS_WQ = WS_WBIN + (size_t)4096 * 1024 * 2;
constexpr size_t WS_WK = WS_WQ + (size_t)2304 * 2048 * 2;
constexpr size_t WS_WV = WS_WK + (size_t)2048 * 2048 * 2;
constexpr size_t WS_WBOUT = WS_WV + (size_t)2304 * 2048 * 2;
constexpr size_t WS_WG = WS_WBOUT + (size_t)1024 * 2048 * 2;
constexpr size_t WS_ZERO = WS_WG + (size_t)2 * 2048 * 8 * 4;
constexpr size_t Z_GATES = 0, Z_SSQ1 = (size_t)TT * 8, Z_SSQ2 = Z_SSQ1 + TT, Z_HST = Z_SSQ2 + TT, Z_END = Z_HST + (size_t)TT * 8;
constexpr size_t WS_XN0 = WS_ZERO + ((Z_END * 4 + 255) & ~(size_t)255);
constexpr size_t WS_X1B = WS_XN0 + SZ_A1;
constexpr size_t WS_U = WS_X1B + SZ_A1;
constexpr size_t WS_GZ = WS_U + SZ_A2;
constexpr size_t WS_YA = WS_GZ + SZ_A2;
constexpr size_t WS_XM = WS_YA + SZ_A2;
constexpr size_t WS_SZ = WS_XM + SZ_A2;
constexpr size_t WS_XC = WS_SZ + SZ_A2;
constexpr size_t WS_Q = WS_XC + SZ_A2;
constexpr size_t WS_KR = WS_Q + SZ_A2;
constexpr size_t WS_KT = WS_KR + SZ_A2;
constexpr size_t WS_VT = WS_KT + SZ_A2;
constexpr size_t WS_OB = WS_VT + SZ_A2;
constexpr size_t WS_X1 = WS_OB + SZ_A2;
constexpr size_t WS_H = WS_X1 + (size_t)TT * DM * 4;
constexpr size_t WS_SRAW = WS_H + (size_t)TT * WD * 4;
constexpr size_t WS_BAR = WS_SRAW + (size_t)1024 * 4096 * 4;
constexpr size_t WS_SC = WS_BAR + 16384;
constexpr size_t WS_END = WS_SC + (size_t)1024 * 64 * 16;
constexpr int LDS_BYTES = 155648;

struct Params {
    const float *x_prompt, *x_sample, *st_conv_a, *st_conv_b, *st_C, *st_n, *st_m, *norm_w, *final_norm_w, *a_w_in, *a_conv_w, *a_w_out,
        *b_w_in, *b_conv_w, *b_conv_b, *b_w_q, *b_w_k, *b_w_v, *b_w_if, *b_b_if, *b_skip, *b_onorm_w, *b_w_out;
    float* out; unsigned char* ws;
};

DI int ltid_(int wv) { int t = wv * 64 + (int)__builtin_amdgcn_mbcnt_hi(~0u, __builtin_amdgcn_mbcnt_lo(~0u, 0u)); asm volatile("" : "+v"(t)); return t; }
#define ltid() ltid_(wv__)
DI unsigned cvt_pk_bf16(float lo, float hi) { unsigned r; asm volatile("v_cvt_pk_bf16_f32 %0, %1, %2" : "=v"(r) : "v"(lo), "v"(hi)); return r; }
DI unsigned f2bf(float f) { unsigned u = __builtin_bit_cast(unsigned, f); return (u + 0x7fffu + ((u >> 16) & 1u)) >> 16; }
DI unsigned pk2(float lo, float hi) { return f2bf(lo) | (f2bf(hi) << 16); }
DI float bflo(unsigned u) { return __uint_as_float(u << 16); }
DI float bfhi(unsigned u) { return __uint_as_float(u & 0xffff0000u); }
DI float silu_f(float x) { return x / (1.f + __expf(-x)); }
DI float log_sigmoid_f(float x) { return fminf(x, 0.f) - log1pf(__expf(-fabsf(x))); }
DI float wave_sum(float v) {
#pragma unroll
    for (int o = 1; o < 64; o <<= 1) v += __shfl_xor(v, o);
    return v;
}
DI void unpack8(u32x4 v, float (&f)[8]) { f[0] = bflo(v.x); f[1] = bfhi(v.x); f[2] = bflo(v.y); f[3] = bfhi(v.y); f[4] = bflo(v.z); f[5] = bfhi(v.z); f[6] = bflo(v.w); f[7] = bfhi(v.w); }
DI void unpack4(u32x2 v, float (&f)[4]) { f[0] = bflo(v.x); f[1] = bfhi(v.x); f[2] = bflo(v.y); f[3] = bfhi(v.y); }

namespace pg8 {
constexpr int BM = 256, BK = 64, HALF = 128, HTB = HALF * BK * 2, STAGE_BYTES = 8 * HTB, NXCD = 8, WGM = 8;
__host__ __device__ __forceinline__ int lds_byte(int r, int c) { const int st = (r >> 4) * 2 + (c >> 5), rr = r & 15, cc = c & 31, ob = rr * 64 + cc * 2; return st * 1024 + (ob ^ (((ob >> 9) & 1) << 5)); }
__host__ __device__ __forceinline__ void stage_rc(int b, int& R, int& C) { const int st = b / 1024, sb = b % 1024, swz = sb ^ (((sb >> 9) & 1) << 5); R = (st >> 1) * 16 + swz / 64; C = (st & 1) * 32 + (swz % 64) / 2; }
__host__ __device__ __forceinline__ int perm32(int rho) { const int n = rho >> 4, i = rho & 15; return 8 * (i >> 2) + 4 * n + (i & 3); }
struct Unit { int pm, pn; };
struct Gemm { const bf16_t* A; const bf16_t* Bt; int M, N, K; int ld = 0; };
struct StaticOrder {
    int nM, nN, nwg, G, c;
    __host__ __device__ __forceinline__ void init(int M, int N, int G_, int c_) { nM = M / BM; nN = N / BM; nwg = nM * nN; G = G_; c = c_; }
    __host__ __device__ __forceinline__ bool next(int i, Unit& u) const {
        const long L = (long)i * G + c; if (L >= nwg) return false;
        int wgid = (int)L; { const int q = nwg / NXCD, r = nwg % NXCD, xcd = wgid % NXCD, off = wgid / NXCD; wgid = (xcd < r ? xcd * (q + 1) : r * (q + 1) + (xcd - r) * q) + off; }
        const int nig = WGM * nN, gid = wgid / nig, fm = gid * WGM, gsz = (nM - fm) < WGM ? (nM - fm) : WGM;
        u.pm = fm + ((wgid % nig) % gsz); u.pn = (wgid % nig) / gsz; return true;
    }
    __device__ __forceinline__ void a_ready(const Unit&) const {}
    __device__ __forceinline__ void done(const Unit&) const {}
};

template <class Epi, class Sched, bool ALIGN_EPI = false, bool SP2 = false>
__device__ __forceinline__ void gemm_phase(LAS unsigned char* lds, const Gemm g, const Sched& S, const Epi& E, const int wv__) {
    const int tid = ltid(), wid = __builtin_amdgcn_readfirstlane(tid >> 6), lane = tid & 63, wr = wid >> 2, wc = wid & 3, fr = lane & 15, fq = lane >> 4;
    const int K = g.K, nt = K / BK, ld = g.ld ? g.ld : g.K;
    unsigned voffA[2], voffB[2];
#pragma unroll
    for (int i = 0; i < 2; ++i) { int R, C; stage_rc(tid * 16 + i * 8192, R, C); const int Rb = Epi::PERM ? ((R & ~31) + perm32(R & 31)) : R;
        voffA[i] = (unsigned)(R * ld + C) * 2u; voffB[i] = (unsigned)(Rb * ld + C) * 2u; }
    const size_t kstep = (size_t)(BK * 2);
    const size_t hstep = (size_t)HALF * ld * 2;
    const size_t tstep = 2 * hstep;
    const unsigned ldsw = (unsigned)wid * 1024u;
    const int aoff = lds_byte(wr * 64 + fr, fq * 8), boff = lds_byte(wc * 32 + fr, fq * 8);
#define PG8_SA(b, h) (((b) * 2 + (h)) * HTB)
#define PG8_SB(b, h) ((4 + (b) * 2 + (h)) * HTB)
#define PG8_STAGE(bufoff, gbase, voff) do { _Pragma("unroll") for (int _i = 0; _i < 2; ++_i) \
        __builtin_amdgcn_global_load_lds((const unsigned*)((const char*)(gbase) + (voff)[_i]), (LAS unsigned*)(lds + (bufoff) + ldsw + _i * 8192), 16, 0, 0); } while (0)
#define PG8_LDA(dst, b, h) do { _Pragma("unroll") for (int m = 0; m < 4; ++m) _Pragma("unroll") for (int k = 0; k < 2; ++k) dst[m][k] = *(const LAS bf16x8*)(lds + PG8_SA(b, h) + aoff + m * 2048 + k * 1024); } while (0)
#define PG8_LDB(dst, b, h) do { _Pragma("unroll") for (int n = 0; n < 2; ++n) _Pragma("unroll") for (int k = 0; k < 2; ++k) dst[n][k] = *(const LAS bf16x8*)(lds + PG8_SB(b, h) + boff + n * 2048 + k * 1024); } while (0)
#define PG8_MMA(ai, bj, At, Bt) do { __builtin_amdgcn_s_setprio(1); _Pragma("unroll") for (int m = 0; m < 4; ++m) _Pragma("unroll") for (int n = 0; n < 2; ++n) _Pragma("unroll") for (int k = 0; k < 2; ++k) \
        acc[ai][bj][m][n] = Epi::NORMAL ? __builtin_amdgcn_mfma_f32_16x16x32_bf16(At[m][k], Bt[n][k], acc[ai][bj][m][n], 0, 0, 0) \
                                        : __builtin_amdgcn_mfma_f32_16x16x32_bf16(Bt[n][k], At[m][k], acc[ai][bj][m][n], 0, 0, 0); __builtin_amdgcn_s_setprio(0); } while (0)
#define PG8_WAIT_V(n) asm volatile("s_waitcnt vmcnt(" #n ")" ::: "memory")
#define PG8_WAIT_L(n) asm volatile("s_waitcnt lgkmcnt(" #n ")" ::: "memory")
#define PG8_BAR __builtin_amdgcn_s_barrier()
#define PG8_SCHED __builtin_amdgcn_sched_barrier(0)
    Unit cur, nxt; int ui = 0;
    if (!S.next(0, cur)) return;
    f32x4 acc[2][2][4][2];
#pragma unroll
    for (int a = 0; a < 2; ++a)
#pragma unroll
        for (int b = 0; b < 2; ++b)
#pragma unroll
            for (int m = 0; m < 4; ++m)
#pragma unroll
                for (int n = 0; n < 2; ++n) acc[a][b][m][n] = (f32x4){0.f, 0.f, 0.f, 0.f};
    bf16x8 At[4][2], B0[2][2], B1[2][2];
    const char* cA = (const char*)g.A + (size_t)cur.pm * tstep; const char* cB = (const char*)g.Bt + (size_t)cur.pn * tstep;
    S.a_ready(cur);
    if constexpr (SP2) {
        PG8_STAGE(PG8_SB(0, 0), cB, voffB); PG8_STAGE(PG8_SB(0, 1), cB + hstep, voffB); PG8_STAGE(PG8_SA(0, 0), cA, voffA); PG8_STAGE(PG8_SA(0, 1), cA + hstep, voffA);
        if (wr == 1) PG8_BAR;
        PG8_WAIT_V(2); PG8_BAR;
        PG8_STAGE(PG8_SB(1, 0), cB + kstep, voffB); PG8_STAGE(PG8_SA(1, 0), cA + kstep, voffA); PG8_STAGE(PG8_SB(1, 1), cB + hstep + kstep, voffB);
        PG8_WAIT_V(6); PG8_BAR;
    } else {
        PG8_STAGE(PG8_SB(0, 0), cB, voffB); PG8_STAGE(PG8_SA(0, 0), cA, voffA); PG8_STAGE(PG8_SB(0, 1), cB + hstep, voffB); PG8_STAGE(PG8_SA(0, 1), cA + hstep, voffA);
        if (wr == 1) PG8_BAR;
        PG8_WAIT_V(4); PG8_BAR;
        PG8_STAGE(PG8_SB(1, 0), cB + kstep, voffB); PG8_STAGE(PG8_SA(1, 0), cA + kstep, voffA); PG8_STAGE(PG8_SB(1, 1), cB + hstep + kstep, voffB);
        PG8_WAIT_V(6); PG8_BAR;
    }
    for (;;) {
        const bool has_next = S.next(ui + 1, nxt);
        const char* nA = has_next ? (const char*)g.A + (size_t)nxt.pm * tstep : cA; const char* nB = has_next ? (const char*)g.Bt + (size_t)nxt.pn * tstep : cB;
        for (int t = 0; t < nt; t += 2) {
            const bool last = (t == nt - 2);
            const char* a1 = cA + (size_t)(t + 1) * kstep;
            const char* a2 = last ? nA : cA + (size_t)(t + 2) * kstep; const char* b2 = last ? nB : cB + (size_t)(t + 2) * kstep;
            const char* a3 = a2 + kstep; const char* b3 = b2 + kstep;
            if (last && has_next) S.a_ready(nxt);
            if constexpr (SP2) {
            PG8_LDB(B0, 0, 0); PG8_LDB(B1, 0, 1); PG8_SCHED; PG8_LDA(At, 0, 0); PG8_STAGE(PG8_SA(1, 1), a1 + hstep, voffA);
            PG8_WAIT_V(8); PG8_WAIT_L(0); PG8_BAR; PG8_MMA(0, 0, At, B0); PG8_MMA(0, 1, At, B1); PG8_BAR; PG8_SCHED;
            PG8_LDA(At, 0, 1); PG8_STAGE(PG8_SB(0, 0), b2, voffB); PG8_STAGE(PG8_SB(0, 1), b2 + hstep, voffB); PG8_STAGE(PG8_SA(0, 0), a2, voffA);
            PG8_WAIT_V(8); PG8_WAIT_L(0); PG8_BAR; PG8_MMA(1, 0, At, B0); PG8_MMA(1, 1, At, B1); PG8_BAR; PG8_SCHED;
            PG8_LDB(B0, 1, 0); PG8_LDB(B1, 1, 1); PG8_SCHED; PG8_LDA(At, 1, 0); PG8_STAGE(PG8_SA(0, 1), a2 + hstep, voffA);
            PG8_WAIT_V(8); PG8_WAIT_L(0); PG8_BAR; PG8_MMA(0, 0, At, B0); PG8_MMA(0, 1, At, B1); PG8_BAR; PG8_SCHED;
            PG8_LDA(At, 1, 1); PG8_STAGE(PG8_SB(1, 0), b3, voffB); PG8_STAGE(PG8_SB(1, 1), b3 + hstep, voffB); PG8_STAGE(PG8_SA(1, 0), a3, voffA);
            PG8_WAIT_V(8); PG8_WAIT_L(0); PG8_BAR; PG8_MMA(1, 0, At, B0); PG8_MMA(1, 1, At, B1); PG8_BAR; PG8_SCHED;
            } else {
            PG8_LDB(B0, 0, 0); PG8_SCHED; PG8_LDA(At, 0, 0); PG8_STAGE(PG8_SA(1, 1), a1 + hstep, voffA);
            PG8_WAIT_L(8); PG8_BAR; PG8_WAIT_L(0); PG8_MMA(0, 0, At, B0); PG8_BAR; PG8_SCHED;
            PG8_LDB(B1, 0, 1); PG8_STAGE(PG8_SB(0, 0), b2, voffB);
            PG8_BAR; PG8_WAIT_L(0); PG8_MMA(0, 1, At, B1); PG8_BAR;
            PG8_LDA(At, 0, 1); PG8_STAGE(PG8_SA(0, 0), a2, voffA);
            PG8_BAR; PG8_WAIT_L(0); PG8_MMA(1, 0, At, B0); PG8_BAR; PG8_SCHED;
            PG8_STAGE(PG8_SB(0, 1), b2 + hstep, voffB);
            PG8_WAIT_V(6); PG8_BAR; PG8_MMA(1, 1, At, B1); PG8_BAR;
            PG8_LDB(B0, 1, 0); PG8_SCHED; PG8_LDA(At, 1, 0); PG8_STAGE(PG8_SA(0, 1), a2 + hstep, voffA);
            PG8_WAIT_L(8); PG8_BAR; PG8_WAIT_L(0); PG8_MMA(0, 0, At, B0); PG8_BAR; PG8_SCHED;
            PG8_LDB(B1, 1, 1); PG8_STAGE(PG8_SB(1, 0), b3, voffB);
            PG8_BAR; PG8_WAIT_L(0); PG8_MMA(0, 1, At, B1); PG8_BAR;
            PG8_LDA(At, 1, 1); PG8_STAGE(PG8_SA(1, 0), a3, voffA);
            PG8_BAR; PG8_WAIT_L(0); PG8_MMA(1, 0, At, B0); PG8_BAR; PG8_SCHED;
            PG8_STAGE(PG8_SB(1, 1), b3 + hstep, voffB);
            PG8_WAIT_V(6); PG8_BAR; PG8_MMA(1, 1, At, B1); PG8_BAR;
            }
        }
        if constexpr (ALIGN_EPI) { if (wr == 0) PG8_BAR; }
        E(acc, cur, wr, wc, fr, fq); S.done(cur);
        if (!has_next) break;
#pragma unroll
        for (int a = 0; a < 2; ++a)
#pragma unroll
            for (int b = 0; b < 2; ++b)
#pragma unroll
                for (int m = 0; m < 4; ++m)
#pragma unroll
                    for (int n = 0; n < 2; ++n) acc[a][b][m][n] = (f32x4){0.f, 0.f, 0.f, 0.f};
        cur = nxt; cA = nA; cB = nB; ++ui;
        if constexpr (ALIGN_EPI) { if (wr == 1) PG8_BAR; }
    }
    PG8_WAIT_V(0);
    if constexpr (!ALIGN_EPI) { if (wr == 0) PG8_BAR; }
    PG8_BAR;
#undef PG8_SA
#undef PG8_SB
#undef PG8_STAGE
#undef PG8_LDA
#undef PG8_LDB
#undef PG8_MMA
#undef PG8_WAIT_V
#undef PG8_WAIT_L
#undef PG8_BAR
#undef PG8_SCHED
}
}
using pg8::Unit;

struct EpiAin {
    static constexpr bool PERM = false, AFTER_DRAIN = false, NORMAL = false;
    bf16_t* U; bf16_t* GZ; bf16_t* YA; float* out; const float* cw; const float* sca;
    DI void operator()(const f32x4 (&acc)[2][2][4][2], const Unit& u, int wr, int wc, int fr, int fq) const {
        const int ch0 = u.pn * 64 + wc * 16 + fq * 4, lane = fq * 16 + fr;
        const f32x4 w0 = *(const f32x4*)(cw + ch0), w1 = *(const f32x4*)(cw + WD + ch0), w2 = *(const f32x4*)(cw + 2 * WD + ch0);
#pragma unroll
        for (int ai = 0; ai < 2; ++ai) {
            f32x4 prev = {0.f, 0.f, 0.f, 0.f};
#pragma unroll
            for (int m = 0; m < 4; ++m) {
                const int row = u.pm * 256 + ai * 128 + wr * 64 + m * 16 + fr;
                const f32x4 b = acc[ai][0][m][0], c = acc[ai][0][m][1], xa = acc[ai][1][m][0], z = acc[ai][1][m][1];
                const f32x4 uu = c * xa; f32x4 gz, u1, u2;
#pragma unroll
                for (int e = 0; e < 4; ++e) {
                    gz[e] = b[e] * silu_f(z[e]);
                    const float c1 = __shfl(uu[e], lane - 1), c2 = __shfl(uu[e], lane - 2), p1 = __shfl(prev[e], (lane & 48) + 15), p2 = __shfl(prev[e], (lane & 48) + 14);
                    u1[e] = fr >= 1 ? c1 : p1; u2[e] = fr >= 2 ? c2 : (fr == 1 ? p1 : p2);
                }
                bool valid = true; float* dst = nullptr;
                if (row >= TP) {
                    const int t = row & 7, bb = (row - TP) >> 3;
                    if (t < 2) { const f32x4 b1 = *(const f32x4*)(sca + (size_t)(bb * 2 + 1) * WD + ch0);
                        if (t == 0) { u1 = b1; u2 = *(const f32x4*)(sca + (size_t)(bb * 2) * WD + ch0); } else u2 = b1; }
                    if (t >= 6) dst = out + O_CAS + (size_t)(bb * 2 + (t - 6)) * WD;
                } else {
                    const int t = row & 2047;
                    if (t == 0) { u1 = (f32x4){0.f, 0.f, 0.f, 0.f}; u2 = u1; } else if (t == 1) u2 = (f32x4){0.f, 0.f, 0.f, 0.f}; else if (m == 0 && fr < 2) valid = false;
                    if (t >= 2046) dst = out + O_CAP + (size_t)((row >> 11) * 2 + (t - 2046)) * WD;
                    u32x2 pk; pk.x = cvt_pk_bf16(uu[0], uu[1]); pk.y = cvt_pk_bf16(uu[2], uu[3]);
                    if ((m == 3 && fr >= 14) || (m == 0 && fr < 2)) *(u32x2*)(U + (size_t)row * WD + ch0) = pk;
                    if (m == 0 && fr < 2) { u32x2 pg; pg.x = cvt_pk_bf16(gz[0], gz[1]); pg.y = cvt_pk_bf16(gz[2], gz[3]); *(u32x2*)(GZ + (size_t)row * WD + ch0) = pg; }
                }
                if (valid) { const f32x4 y = gz * (w0 * u2 + w1 * u1 + w2 * uu); u32x2 py; py.x = cvt_pk_bf16(y[0], y[1]); py.y = cvt_pk_bf16(y[2], y[3]); *(u32x2*)(YA + (size_t)row * WD + ch0) = py; }
                if (dst) *(f32x4*)(dst + ch0) = uu;
                prev = uu;
            }
        }
    }
};
DI void convA_fixup_panel(const Params& p, int pm, const int wv__) {
    if (pm >= TP / 256) return;
    const bf16_t* U = (const bf16_t*)(p.ws + WS_U); const bf16_t* GZ = (const bf16_t*)(p.ws + WS_GZ); bf16_t* YA = (bf16_t*)(p.ws + WS_YA);
    const int ch = 4 * ltid();
    const f32x4 w0 = *(const f32x4*)(p.a_conv_w + ch), w1 = *(const f32x4*)(p.a_conv_w + WD + ch), w2 = *(const f32x4*)(p.a_conv_w + 2 * WD + ch);
#pragma unroll
    for (int k = 0; k < 4; ++k) {
        const int r0 = pm * 256 + 64 * k;
        if ((r0 & 2047) == 0) continue;
        float um2[4], um1[4], u0[4], u1[4], g0[4], g1[4];
        unpack4(*(const u32x2*)(U + (size_t)(r0 - 2) * WD + ch), um2); unpack4(*(const u32x2*)(U + (size_t)(r0 - 1) * WD + ch), um1);
        unpack4(*(const u32x2*)(U + (size_t)r0 * WD + ch), u0); unpack4(*(const u32x2*)(U + (size_t)(r0 + 1) * WD + ch), u1);
        unpack4(*(const u32x2*)(GZ + (size_t)r0 * WD + ch), g0); unpack4(*(const u32x2*)(GZ + (size_t)(r0 + 1) * WD + ch), g1);
        float y0[4], y1[4];
#pragma unroll
        for (int e = 0; e < 4; ++e) { y0[e] = g0[e] * (w0[e] * um2[e] + w1[e] * um1[e] + w2[e] * u0[e]); y1[e] = g1[e] * (w0[e] * um1[e] + w1[e] * u0[e] + w2[e] * u1[e]); }
        u32x2 a; a.x = pk2(y0[0], y0[1]); a.y = pk2(y0[2], y0[3]); u32x2 bq; bq.x = pk2(y1[0], y1[1]); bq.y = pk2(y1[2], y1[3]);
        *(u32x2*)(YA + (size_t)r0 * WD + ch) = a; *(u32x2*)(YA + (size_t)(r0 + 1) * WD + ch) = bq;
    }
}
struct EpiRes {
    static constexpr bool PERM = false, AFTER_DRAIN = false, NORMAL = false;
    const float* xa; const float* xb; int split; float* xo; bf16_t* xob; float* ssq;
    DI void operator()(const f32x4 (&acc)[2][2][4][2], const Unit& u, int wr, int wc, int fr, int fq) const {
        const int col0 = u.pn * 256 + wc * 32 + 4 * fq;
#pragma unroll
        for (int ai = 0; ai < 2; ++ai)
#pragma unroll
            for (int m = 0; m < 4; ++m) {
                const int row = u.pm * 256 + ai * 128 + wr * 64 + m * 16 + fr;
                const float* xr = row < split ? xa + (size_t)row * DM : xb + (size_t)(row - split) * DM;
                float s = 0.f;
#pragma unroll
                for (int bj = 0; bj < 2; ++bj)
#pragma unroll
                    for (int n = 0; n < 2; ++n) {
                        const int c = col0 + bj * 128 + n * 16;
                        const f32x4 v = *(const f32x4*)(xr + c) + acc[ai][bj][m][n];
                        *(f32x4*)(xo + (size_t)row * DM + c) = v;
                        if (xob) { u32x2 w; w.x = cvt_pk_bf16(v[0], v[1]); w.y = cvt_pk_bf16(v[2], v[3]); *(u32x2*)(xob + (size_t)row * DM + c) = w; }
                        s += (v[0] * v[0] + v[1] * v[1]) + (v[2] * v[2] + v[3] * v[3]);
                    }
                s += __shfl_xor(s, 16); s += __shfl_xor(s, 32);
                if (fq == 0 && ssq) atomicAdd(ssq + row, s);
            }
    }
};
struct PanelOrder {
    int c;
    DI bool next(int i, Unit& u) const { if (i > 0 || c >= 256) return false; const int x = c & 7, j = c >> 3; u.pm = x * 8 + (j >> 2); u.pn = j & 3; return true; }
    DI void a_ready(const Unit&) const {}
    DI void done(const Unit&) const {}
};
struct SliceOrder {
    int c;
    DI bool next(int i, Unit& u) const { if (i > 0 || c >= 128) return false; const int ui = c & 15; u.pm = 64 + (ui >> 2); u.pn = ui & 3; return true; }
    DI void a_ready(const Unit&) const {}
    DI void done(const Unit&) const {}
};
struct EpiResAtomic {
    static constexpr bool PERM = false, AFTER_DRAIN = false, NORMAL = false;
    const float* xin; float* xo; int add_res;
    DI void operator()(const f32x4 (&acc)[2][2][4][2], const Unit& u, int wr, int wc, int fr, int fq) const {
        const int col0 = u.pn * 256 + wc * 32 + 4 * fq;
#pragma unroll
        for (int ai = 0; ai < 2; ++ai)
#pragma unroll
            for (int m = 0; m < 4; ++m) {
                const int row = u.pm * 256 + ai * 128 + wr * 64 + m * 16 + fr;
#pragma unroll
                for (int bj = 0; bj < 2; ++bj)
#pragma unroll
                    for (int n = 0; n < 2; ++n) {
                        const int c = col0 + bj * 128 + n * 16; f32x4 v = acc[ai][bj][m][n];
                        if (add_res) v += *(const f32x4*)(xin + (size_t)row * DM + c);
                        float* o = xo + (size_t)row * DM + c;
#pragma unroll
                        for (int e = 0; e < 4; ++e) atomicAdd(o + e, v[e]);
                    }
            }
    }
};
struct EpiBin {
    static constexpr bool PERM = true, AFTER_DRAIN = false, NORMAL = false;
    const float* ssq1; bf16_t* XM; bf16_t* SZ; float* out;
    DI void operator()(const f32x4 (&acc)[2][2][4][2], const Unit& u, int wr, int wc, int fr, int fq) const {
        const bool isz = u.pn >= 8; const int col0 = (u.pn & 7) * 256 + wc * 32 + 8 * fq; const size_t zoff = isz ? (size_t)((WS_SZ - WS_XM) / 2) : (size_t)0;
#pragma unroll
        for (int ai = 0; ai < 2; ++ai)
#pragma unroll
            for (int m = 0; m < 4; ++m) {
                const int row = u.pm * 256 + ai * 128 + wr * 64 + m * 16 + fr;
                const float rs = rsqrtf(ssq1[row] * (1.f / DM) + 1e-6f);
                float* dst = nullptr;
                if (!isz) {
                    if (row < TP) { const int t = row & 2047; if (t >= 2045) dst = out + O_CBP + (size_t)((row >> 11) * 3 + (t - 2045)) * WD; }
                    else { const int t = row & 7; if (t >= 5) dst = out + O_CBS + (size_t)(((row - TP) >> 3) * 3 + (t - 5)) * WD; }
                }
#pragma unroll
                for (int bj = 0; bj < 2; ++bj) {
                    f32x4 v0 = acc[ai][bj][m][0] * rs, v1 = acc[ai][bj][m][1] * rs; const int c = col0 + bj * 128;
                    if (isz) {
#pragma unroll
                        for (int e = 0; e < 4; ++e) { v0[e] = silu_f(v0[e]); v1[e] = silu_f(v1[e]); }
                    } else if (dst) { *(f32x4*)(dst + c) = v0; *(f32x4*)(dst + c + 4) = v1; }
                    u32x4 w; w.x = cvt_pk_bf16(v0[0], v0[1]); w.y = cvt_pk_bf16(v0[2], v0[3]); w.z = cvt_pk_bf16(v1[0], v1[1]); w.w = cvt_pk_bf16(v1[2], v1[3]);
                    *(u32x4*)(XM + zoff + (size_t)row * WD + c) = w;
                }
            }
    }
};
struct EpiQ {
    static constexpr bool PERM = true, AFTER_DRAIN = false, NORMAL = false;
    bf16_t* Q; float* gates;
    DI void operator()(const f32x4 (&acc)[2][2][4][2], const Unit& u, int wr, int wc, int fr, int fq) const {
        if (u.pn == 8) {
            if (wc == 0 && fq == 0) {
#pragma unroll
                for (int ai = 0; ai < 2; ++ai)
#pragma unroll
                    for (int m = 0; m < 4; ++m) { float* gp = gates + (size_t)(u.pm * 256 + ai * 128 + wr * 64 + m * 16 + fr) * 8;
#pragma unroll
                        for (int e = 0; e < 4; ++e) { atomicAdd(gp + e, acc[ai][0][m][0][e]); atomicAdd(gp + 4 + e, acc[ai][0][m][1][e]); } }
            }
            return;
        }
        const int col0 = u.pn * 256 + wc * 32 + 8 * fq;
#pragma unroll
        for (int ai = 0; ai < 2; ++ai)
#pragma unroll
            for (int m = 0; m < 4; ++m) {
                const int row = u.pm * 256 + ai * 128 + wr * 64 + m * 16 + fr;
#pragma unroll
                for (int bj = 0; bj < 2; ++bj) {
                    const f32x4 v0 = acc[ai][bj][m][0], v1 = acc[ai][bj][m][1];
                    u32x4 w; w.x = cvt_pk_bf16(v0[0], v0[1]); w.y = cvt_pk_bf16(v0[2], v0[3]); w.z = cvt_pk_bf16(v1[0], v1[1]); w.w = cvt_pk_bf16(v1[2], v1[3]);
                    *(u32x4*)(Q + (size_t)row * WD + col0 + bj * 128) = w;
                }
            }
    }
};
struct EpiKV {
    static constexpr bool PERM = false, AFTER_DRAIN = false, NORMAL = true;
    bf16_t* XT; bf16_t* XR; float* gates;
    DI void operator()(const f32x4 (&acc)[2][2][4][2], const Unit& u, int wr, int wc, int fr, int fq) const {
        if (u.pn == 8) {
            if (wc == 0 && fr < 8) {
#pragma unroll
                for (int ai = 0; ai < 2; ++ai)
#pragma unroll
                    for (int m = 0; m < 4; ++m) { float* gp = gates + (size_t)(u.pm * 256 + ai * 128 + wr * 64 + m * 16 + 4 * fq) * 8 + fr;
#pragma unroll
                        for (int j = 0; j < 4; ++j) atomicAdd(gp + 8 * j, acc[ai][0][m][0][j]); }
            }
            return;
        }
#pragma unroll
        for (int ai = 0; ai < 2; ++ai)
#pragma unroll
            for (int m = 0; m < 4; ++m) {
                const int row0 = u.pm * 256 + ai * 128 + wr * 64 + m * 16 + 4 * fq;
#pragma unroll
                for (int bj = 0; bj < 2; ++bj)
#pragma unroll
                    for (int n = 0; n < 2; ++n) {
                        const int col = u.pn * 256 + bj * 128 + wc * 32 + n * 16 + fr; const f32x4 v = acc[ai][bj][m][n];
                        u32x2 w; w.x = cvt_pk_bf16(v[0], v[1]); w.y = cvt_pk_bf16(v[2], v[3]);
                        *(u32x2*)(XT + ((size_t)(row0 >> 2) * WD + col) * 4) = w;
                        if (XR) {
                            XR[(size_t)(row0 + 0) * WD + col] = (bf16_t)(w.x & 0xffffu); XR[(size_t)(row0 + 1) * WD + col] = (bf16_t)(w.x >> 16);
                            XR[(size_t)(row0 + 2) * WD + col] = (bf16_t)(w.y & 0xffffu); XR[(size_t)(row0 + 3) * WD + col] = (bf16_t)(w.y >> 16);
                        }
                    }
            }
    }
};

template <int MODE>
DI void p0_transpose_item(const float* W, int K, int N, bf16_t* WT, const float* kscale, LAS float* scr, int item, int lane) {
    const int nblk = N / 32, kb = item / nblk, nb = item % nblk, k0 = 64 * kb, n0 = 32 * nb;
#pragma unroll 32
    for (int i = 0; i < 32; ++i) { const int kk = 2 * i + (lane >> 5); float v = W[(size_t)(k0 + kk) * N + n0 + (lane & 31)]; if (kscale) v *= kscale[k0 + kk]; scr[kk * 33 + (lane & 31)] = v; }
    asm volatile("s_waitcnt lgkmcnt(0)" ::: "memory");
    const int c = lane & 7;
#pragma unroll
    for (int j = 0; j < 4; ++j) { const int n = (lane >> 3) + 8 * j; const LAS float* s = scr + (8 * c) * 33 + n;
        u32x4 o; o.x = pk2(s[0 * 33], s[1 * 33]); o.y = pk2(s[2 * 33], s[3 * 33]); o.z = pk2(s[4 * 33], s[5 * 33]); o.w = pk2(s[6 * 33], s[7 * 33]);
        int src = n0 + n, dest = src;
        if (MODE == 1) { const int type = src >> 11, pn = (src & 2047) >> 6, ch = src & 63; dest = 256 * pn + 128 * (type >> 1) + 16 * (type & 1) + 32 * (ch >> 4) + (ch & 15); }
        *(u32x4*)(WT + (size_t)dest * K + k0 + 8 * c) = o; }
    asm volatile("s_waitcnt lgkmcnt(0)" ::: "memory");
}
DI void phase0(const Params& p, LAS unsigned char* lds, int G, const int wv__) {
    const int tid = ltid(), lane = tid & 63, wave = tid >> 6;
    unsigned char* ws = p.ws;
    LAS float* scr = (LAS float*)(lds + wave * 16384);
    const int gw = blockIdx.x * 8 + wave, NGW = G * 8;
    { float* z = (float*)(ws + WS_ZERO); for (size_t i = (size_t)blockIdx.x * 512 + tid; i < Z_END; i += (size_t)G * 512) z[i] = 0.f; }
    constexpr int I0 = 16 * 256, I1 = 32 * 32, I2 = 16 * 128, I3 = 32 * 64, I4 = 32 * 32, NIT = I0 + I1 + I2 + 3 * I3 + I4;
    for (int it = gw; it < NIT; it += NGW) {
        int r = it;
        if (r < I0) { p0_transpose_item<1>(p.a_w_in, 1024, 8192, (bf16_t*)(ws + WS_WAIN), nullptr, scr, r, lane); continue; } r -= I0;
        if (r < I1) { p0_transpose_item<0>(p.a_w_out, 2048, 1024, (bf16_t*)(ws + WS_WAOUT), nullptr, scr, r, lane); continue; } r -= I1;
        if (r < I2) { p0_transpose_item<0>(p.b_w_in, 1024, 4096, (bf16_t*)(ws + WS_WBIN), p.norm_w + DM, scr, r, lane); continue; } r -= I2;
        if (r < I3) { p0_transpose_item<0>(p.b_w_q, 2048, 2048, (bf16_t*)(ws + WS_WQ), nullptr, scr, r, lane); continue; } r -= I3;
        if (r < I3) { p0_transpose_item<0>(p.b_w_k, 2048, 2048, (bf16_t*)(ws + WS_WK), nullptr, scr, r, lane); continue; } r -= I3;
        if (r < I3) { p0_transpose_item<0>(p.b_w_v, 2048, 2048, (bf16_t*)(ws + WS_WV), nullptr, scr, r, lane); continue; } r -= I3;
        p0_transpose_item<0>(p.b_w_out, 2048, 1024, (bf16_t*)(ws + WS_WBOUT), nullptr, scr, r, lane);
    }
    {
        f32x4 nw[4];
#pragma unroll
        for (int j = 0; j < 4; ++j) nw[j] = *(const f32x4*)(p.norm_w + 4 * lane + 256 * j);
        for (int row = gw; row < TT; row += 2 * NGW) {
            const int row2 = (row + NGW < TT) ? row + NGW : row;
            const float* xa = row < TP ? p.x_prompt + (size_t)row * DM : p.x_sample + (size_t)(row - TP) * DM;
            const float* xb = row2 < TP ? p.x_prompt + (size_t)row2 * DM : p.x_sample + (size_t)(row2 - TP) * DM;
            f32x4 va[4], vb[4]; float sa = 0.f, sb = 0.f;
#pragma unroll
            for (int j = 0; j < 4; ++j) { va[j] = *(const f32x4*)(xa + 4 * lane + 256 * j); vb[j] = *(const f32x4*)(xb + 4 * lane + 256 * j); }
#pragma unroll
            for (int j = 0; j < 4; ++j) { sa += (va[j][0] * va[j][0] + va[j][1] * va[j][1]) + (va[j][2] * va[j][2] + va[j][3] * va[j][3]); sb += (vb[j][0] * vb[j][0] + vb[j][1] * vb[j][1]) + (vb[j][2] * vb[j][2] + vb[j][3] * vb[j][3]); }
            const float ra = rsqrtf(wave_sum(sa) * (1.f / DM) + 1e-6f), rb = rsqrtf(wave_sum(sb) * (1.f / DM) + 1e-6f);
            bf16_t* oa = (bf16_t*)(ws + WS_XN0) + (size_t)row * DM; bf16_t* ob = (bf16_t*)(ws + WS_XN0) + (size_t)row2 * DM;
#pragma unroll
            for (int j = 0; j < 4; ++j) {
                u32x2 pa; pa.x = pk2(va[j][0] * ra * nw[j][0], va[j][1] * ra * nw[j][1]); pa.y = pk2(va[j][2] * ra * nw[j][2], va[j][3] * ra * nw[j][3]);
                u32x2 pb; pb.x = pk2(vb[j][0] * rb * nw[j][0], vb[j][1] * rb * nw[j][1]); pb.y = pk2(vb[j][2] * rb * nw[j][2], vb[j][3] * rb * nw[j][3]);
                *(u32x2*)(oa + 4 * lane + 256 * j) = pa; *(u32x2*)(ob + 4 * lane + 256 * j) = pb; }
        }
    }
    for (int task = gw; task < 2 * 2048; task += NGW) {
        const int set = task / 2048, ch = task % 2048;
        float a[8];
#pragma unroll
        for (int g = 0; g < 8; ++g) a[g] = 0.f;
        for (int mm = 0; mm < 2; ++mm) {
            if (set == 1 && mm == 1) break;
            const int mat = set == 1 ? 2 : mm;
            const float* W = (mat == 0 ? p.b_w_q : (mat == 1 ? p.b_w_k : p.b_w_v)) + (size_t)ch * 2048;
            const float* wif = p.b_w_if + (size_t)mat * 2048 * 8;
#pragma unroll 8
            for (int i = 0; i < 32; ++i) { const int n = lane + 64 * i; const float w = W[n]; const f32x4 f0 = *(const f32x4*)(wif + (size_t)n * 8), f1 = *(const f32x4*)(wif + (size_t)n * 8 + 4);
#pragma unroll
                for (int g = 0; g < 4; ++g) { a[g] += w * f0[g]; a[4 + g] += w * f1[g]; } }
        }
#pragma unroll
        for (int g = 0; g < 8; ++g) a[g] = wave_sum(a[g]);
        if (lane == 0) {
            bf16_t* bt = (bf16_t*)(ws + (set == 0 ? WS_WQ : WS_WV));
#pragma unroll
            for (int g = 0; g < 8; ++g) bt[(size_t)(2048 + g) * 2048 + ch] = (bf16_t)f2bf(a[g]);
        }
    }
    for (size_t i = (size_t)blockIdx.x * 512 + tid; i < (size_t)2 * 63488; i += (size_t)G * 512) {
        const size_t j = i % 63488; u32x4* z = (u32x4*)(ws + (i < 63488 ? WS_WQ : WS_WV) + (size_t)2056 * 2048 * 2) + j; *z = (u32x4){0u, 0u, 0u, 0u}; }
}

DI void phase_convB(const Params& p, int G, bool do_gates, const int wv__) {
    const bf16_t* XM = (const bf16_t*)(p.ws + WS_XM); bf16_t* XC = (bf16_t*)(p.ws + WS_XC);
    const float* WG = (const float*)(p.ws + WS_WG); float* gates = (float*)(p.ws + WS_ZERO) + Z_GATES;
    const int lane = ltid() & 63;
    const int ntask = (TT / 8) * 512;
    for (int task = blockIdx.x * 512 + ltid(); task < ntask; task += G * 512) {
        const int cg4 = task & 511, rb = task >> 9, row0 = rb * 8, ch = cg4 * 4;
        float cw[4][4], cb[4], p3[4], p2[4], p1[4]; f32x4 wg0[4][2], wg1[4][2];
#pragma unroll
        for (int e = 0; e < 4; ++e) { cb[e] = p.b_conv_b[ch + e];
#pragma unroll
            for (int j = 0; j < 4; ++j) cw[j][e] = p.b_conv_w[j * WD + ch + e];
            wg0[e][0] = *(const f32x4*)(WG + (size_t)(ch + e) * 8); wg0[e][1] = *(const f32x4*)(WG + (size_t)(ch + e) * 8 + 4);
            wg1[e][0] = *(const f32x4*)(WG + (size_t)(2048 + ch + e) * 8); wg1[e][1] = *(const f32x4*)(WG + (size_t)(2048 + ch + e) * 8 + 4); }
        if (row0 >= TP) { const int b = (row0 - TP) >> 3;
#pragma unroll
            for (int e = 0; e < 4; ++e) { p3[e] = p.st_conv_b[(size_t)(b * 3 + 0) * WD + ch + e]; p2[e] = p.st_conv_b[(size_t)(b * 3 + 1) * WD + ch + e]; p1[e] = p.st_conv_b[(size_t)(b * 3 + 2) * WD + ch + e]; } }
        else if ((row0 & 2047) == 0) {
#pragma unroll
            for (int e = 0; e < 4; ++e) { p3[e] = 0.f; p2[e] = 0.f; p1[e] = 0.f; } }
        else { unpack4(*(const u32x2*)(XM + (size_t)(row0 - 3) * WD + ch), p3); unpack4(*(const u32x2*)(XM + (size_t)(row0 - 2) * WD + ch), p2); unpack4(*(const u32x2*)(XM + (size_t)(row0 - 1) * WD + ch), p1); }
        float gv[64];
#pragma unroll
        for (int r = 0; r < 8; ++r) {
            float xm[4], xc[4];
            unpack4(*(const u32x2*)(XM + (size_t)(row0 + r) * WD + ch), xm);
            f32x4 g0 = {0.f, 0.f, 0.f, 0.f}, g1 = {0.f, 0.f, 0.f, 0.f};
#pragma unroll
            for (int e = 0; e < 4; ++e) { xc[e] = silu_f(cb[e] + cw[0][e] * p3[e] + cw[1][e] * p2[e] + cw[2][e] * p1[e] + cw[3][e] * xm[e]); p3[e] = p2[e]; p2[e] = p1[e]; p1[e] = xm[e];
                if (do_gates) { g0 += wg0[e][0] * xc[e] + wg1[e][0] * xm[e]; g1 += wg0[e][1] * xc[e] + wg1[e][1] * xm[e]; } }
            u32x2 o; o.x = pk2(xc[0], xc[1]); o.y = pk2(xc[2], xc[3]);
            *(u32x2*)(XC + (size_t)(row0 + r) * WD + ch) = o;
#pragma unroll
            for (int g = 0; g < 4; ++g) { gv[r * 8 + g] = g0[g]; gv[r * 8 + 4 + g] = g1[g]; }
        }
#pragma unroll
        for (int m = 32, n = 64; do_gates && m >= 1; m >>= 1, n >>= 1) {
            const bool up = (lane & m) != 0;
#pragma unroll
            for (int i = 0; i < 32; ++i) if (i < n / 2) {
                const float keep = up ? gv[i + n / 2] : gv[i], send = up ? gv[i] : gv[i + n / 2];
                gv[i] = keep + __shfl_xor(send, m);
            }
        }
        if (do_gates) atomicAdd(gates + (size_t)(row0 + (lane >> 3)) * 8 + (lane & 7), gv[0]);
    }
}

DI void phase_convB8(const Params& p, int G, const int wv__) {
    const bf16_t* XM = (const bf16_t*)(p.ws + WS_XM); bf16_t* XC = (bf16_t*)(p.ws + WS_XC);
    const int ntask = (TT / 8) * 256;
    for (int task = blockIdx.x * 512 + ltid(); task < ntask; task += G * 512) {
        const int cg8 = task & 255, rb = task >> 8, row0 = rb * 8, ch = cg8 * 8;
        float w0[8], w1[8], w2[8], w3[8], cb[8], p3[8], p2[8], p1[8];
#pragma unroll
        for (int e = 0; e < 8; ++e) { w0[e] = p.b_conv_w[ch + e]; w1[e] = p.b_conv_w[WD + ch + e]; w2[e] = p.b_conv_w[2 * WD + ch + e]; w3[e] = p.b_conv_w[3 * WD + ch + e]; cb[e] = p.b_conv_b[ch + e]; }
        if (row0 >= TP) { const int b = (row0 - TP) >> 3;
#pragma unroll
            for (int e = 0; e < 8; ++e) { p3[e] = p.st_conv_b[(size_t)(b * 3 + 0) * WD + ch + e]; p2[e] = p.st_conv_b[(size_t)(b * 3 + 1) * WD + ch + e]; p1[e] = p.st_conv_b[(size_t)(b * 3 + 2) * WD + ch + e]; } }
        else if ((row0 & 2047) == 0) {
#pragma unroll
            for (int e = 0; e < 8; ++e) { p3[e] = 0.f; p2[e] = 0.f; p1[e] = 0.f; } }
        else { unpack8(*(const u32x4*)(XM + (size_t)(row0 - 3) * WD + ch), p3); unpack8(*(const u32x4*)(XM + (size_t)(row0 - 2) * WD + ch), p2); unpack8(*(const u32x4*)(XM + (size_t)(row0 - 1) * WD + ch), p1); }
#pragma unroll
        for (int r = 0; r < 8; ++r) {
            float xm[8], y[8];
            unpack8(*(const u32x4*)(XM + (size_t)(row0 + r) * WD + ch), xm);
#pragma unroll
            for (int e = 0; e < 8; ++e) { y[e] = silu_f(cb[e] + w0[e] * p3[e] + w1[e] * p2[e] + w2[e] * p1[e] + w3[e] * xm[e]); p3[e] = p2[e]; p2[e] = p1[e]; p1[e] = xm[e]; }
            u32x4 o; o.x = pk2(y[0], y[1]); o.y = pk2(y[2], y[3]); o.z = pk2(y[4], y[5]); o.w = pk2(y[6], y[7]);
            *(u32x4*)(XC + (size_t)(row0 + r) * WD + ch) = o;
        }
    }
}

DI void phase_sraw(const Params& p, int G, const int wv__) {
    const bf16_t* Q = (const bf16_t*)(p.ws + WS_Q); const bf16_t* KR = (const bf16_t*)(p.ws + WS_KR); float* SR = (float*)(p.ws + WS_SRAW);
    const int lane = ltid() & 63, w = ltid() >> 6, r = lane & 15, q4 = lane >> 4;
    for (int item = blockIdx.x; item < 1024; item += G) {
        const int bh = item >> 5, c = item & 31, b = bh >> 2, h = bh & 3, T0 = b * 2048 + 64 * c, F0 = 512 * h;
        const int it = w >> 1;
        if (w == 0) {
            const float* gates = (const float*)(p.ws + WS_ZERO) + Z_GATES;
            const float gi = gates[(size_t)(T0 + lane) * 8 + h] + p.b_b_if[h], gf = gates[(size_t)(T0 + lane) * 8 + 4 + h] + p.b_b_if[4 + h];
            float bc = log_sigmoid_f(gf);
#pragma unroll
            for (int o = 1; o < 64; o <<= 1) { const float t = __shfl_up(bc, o); if (lane >= o) bc += t; }
            const float a = gi - bc; float cm = a;
#pragma unroll
            for (int o = 1; o < 64; o <<= 1) { const float t = __shfl_up(cm, o); if (lane >= o) cm = fmaxf(cm, t); }
            *(f32x4*)(p.ws + WS_SC + ((size_t)item * 64 + lane) * 16) = (f32x4){bc, a, cm, 0.f};
        }
        f32x4 acc[2] = {{0.f, 0.f, 0.f, 0.f}, {0.f, 0.f, 0.f, 0.f}};
        const bf16_t* qa = Q + (size_t)(T0 + 16 * it + r) * WD + F0 + 8 * q4;
        const bf16_t* kb0 = KR + (size_t)(T0 + 16 * ((w & 1) * 2 + 0) + r) * WD + F0 + 8 * q4;
        const bf16_t* kb1 = KR + (size_t)(T0 + 16 * ((w & 1) * 2 + 1) + r) * WD + F0 + 8 * q4;
#pragma unroll 8
        for (int ks = 0; ks < 16; ++ks) {
            const bf16x8 a = *(const bf16x8*)(qa + 32 * ks), b0 = *(const bf16x8*)(kb0 + 32 * ks), b1 = *(const bf16x8*)(kb1 + 32 * ks);
            acc[0] = __builtin_amdgcn_mfma_f32_16x16x32_bf16(a, b0, acc[0], 0, 0, 0);
            acc[1] = __builtin_amdgcn_mfma_f32_16x16x32_bf16(a, b1, acc[1], 0, 0, 0);
        }
#pragma unroll
        for (int d = 0; d < 2; ++d) { const int jt = (w & 1) * 2 + d;
#pragma unroll
            for (int j = 0; j < 4; ++j) SR[((size_t)item * 64 + 16 * it + 4 * q4 + j) * 64 + 16 * jt + r] = acc[d][j]; }
    }
}

DI bf16x8 pack8(f32x4 a, f32x4 b) { u32x4 v; v.x = cvt_pk_bf16(a[0], a[1]); v.y = cvt_pk_bf16(a[2], a[3]); v.z = cvt_pk_bf16(b[0], b[1]); v.w = cvt_pk_bf16(b[2], b[3]); return __builtin_bit_cast(bf16x8, v); }
DI bf16x8 join8(u32x2 a, u32x2 b) { u32x4 v; v.x = a.x; v.y = a.y; v.z = b.x; v.w = b.y; return __builtin_bit_cast(bf16x8, v); }

DI void mlstm_prompt_item(const Params& p, LAS unsigned char* lds, int item, bool stats, const int wv__) {
    const int tid = ltid(), lane = tid & 63, w = tid >> 6, r = lane & 15, q4 = lane >> 4;
    const int bh = item >> 3, s = item & 7, b = bh >> 2, h = bh & 3;
    const bf16_t* Q = (const bf16_t*)(p.ws + WS_Q); const bf16_t* KT = (const bf16_t*)(p.ws + WS_KT); const bf16_t* VT = (const bf16_t*)(p.ws + WS_VT);
    const float* SR = (const float*)(p.ws + WS_SRAW); const float* gates = (const float*)(p.ws + WS_ZERO) + Z_GATES;
    bf16_t* H = (bf16_t*)(p.ws + WS_H); float* hst = (float*)(p.ws + WS_ZERO) + Z_HST;
    LAS f32x4* red = (LAS f32x4*)lds;
    LAS float* qnred = (LAS float*)(lds + 131072);
    LAS float* nbuf = (LAS float*)(lds + 131072 + 2048);
    LAS float* sc = (LAS float*)(lds + 131072 + 4096 + w * 1536);
    LAS float* s_a = sc, *s_M = sc + 64, *s_wg = sc + 128, *s_wi = sc + 192, *s_ei = sc + 256, *s_rs = sc + 320;
    const int D0 = 64 * w, F0 = 512 * h, V0 = 512 * h + 64 * s;
    const unsigned om = (w & 1) ? 0xffffffffu : 0u; const int it_o = w >> 1;
    f32x4 C[4][4];
#pragma unroll
    for (int i = 0; i < 4; ++i)
#pragma unroll
        for (int j = 0; j < 4; ++j) C[i][j] = (f32x4){0.f, 0.f, 0.f, 0.f};
    const unsigned qlane = (unsigned)(r * WD + F0 + D0 + 4 * q4) * 2u, klane = (unsigned)(2 * q4 * WD + F0 + D0 + r) * 8u, vlane = (unsigned)(2 * q4 * WD + V0 + r) * 8u;
    float mst = 0.f;
    nbuf[tid] = 0.f;
    __syncthreads();
    unsigned pfoff;
    {
        const size_t Tb = (size_t)b * 2048;
        size_t o;
        if (tid < 64) o = WS_Q + ((Tb + 8 * s + (tid >> 3)) * WD + F0 + 64 * (tid & 7)) * 2;
        else if (tid < 128) o = WS_KT + ((Tb / 4 + 2 * s + ((tid - 64) >> 5)) * WD + F0) * 8 + 128 * ((tid - 64) & 31);
        else if (tid < 192) o = WS_VT + ((Tb / 4 + ((tid - 128) >> 2)) * WD + V0) * 8 + 128 * ((tid - 128) & 3);
        else { o = WS_SRAW + ((size_t)bh * 32 * 4096) * 4 + 128 * (16 * s + ((tid - 192) & 15)); }
        pfoff = (unsigned)o;
    }
    const f32x4* SC = (const f32x4*)(p.ws + WS_SC) + (size_t)bh * 32 * 64 + lane;
    f32x4 sc_n = SC[0];
    for (int c = 0; c < 32; ++c) {
        const int T0 = b * 2048 + 64 * c;
        u32x2 qa[4][2][2], ka[4][2][2], va[4][2][2];
        {
            int T0s = T0; asm volatile("" : "+s"(T0s));
            const char* qb = (const char*)Q + (size_t)T0s * (WD * 2);
            const char* kb = (const char*)KT + (size_t)(T0s >> 2) * (WD * 8);
            const char* vb = (const char*)VT + (size_t)(T0s >> 2) * (WD * 8);
#pragma unroll
            for (int ks = 0; ks < 2; ++ks) {
#pragma unroll
                for (int it = 0; it < 4; ++it) {
                    qa[it][ks][0] = *(const u32x2*)(qb + (size_t)(it * 16 * WD * 2 + ks * 64) + qlane); qa[it][ks][1] = *(const u32x2*)(qb + (size_t)(it * 16 * WD * 2 + ks * 64 + 32) + qlane); }
            }
#pragma unroll
            for (int ks = 0; ks < 2; ++ks) {
#pragma unroll
                for (int t4 = 0; t4 < 4; ++t4) {
                    ka[t4][ks][0] = *(const u32x2*)(kb + (size_t)((8 * ks * WD + 16 * t4) * 8) + klane); ka[t4][ks][1] = *(const u32x2*)(kb + (size_t)(((8 * ks + 1) * WD + 16 * t4) * 8) + klane);
                    va[t4][ks][0] = *(const u32x2*)(vb + (size_t)((8 * ks * WD + 16 * t4) * 8) + vlane); va[t4][ks][1] = *(const u32x2*)(vb + (size_t)(((8 * ks + 1) * WD + 16 * t4) * 8) + vlane);
                }
            }
        }
        float decay, m_next;
        {
            const float bc = sc_n[0], a = sc_n[1], cm = sc_n[2];
            sc_n = SC[(size_t)(c < 31 ? c + 1 : c) * 64];
            const float gsum = __shfl(bc, 63), amax = __shfl(cm, 63);
            const float Mi = fmaxf(mst, cm), M63 = fmaxf(mst, amax);
            decay = __expf(mst - M63); m_next = gsum + M63;
            s_a[lane] = a; s_M[lane] = Mi; s_wg[lane] = QK_SCALE * __expf(a - M63); s_wi[lane] = __expf(mst - Mi); s_ei[lane] = __expf(-(bc + Mi));
        }
        asm volatile("s_waitcnt lgkmcnt(0)" ::: "memory");
        {
#pragma unroll
            for (int it = 0; it < 4; ++it) {
                f32x4 P[4];
#pragma unroll
                for (int j = 0; j < 4; ++j) P[j] = (f32x4){0.f, 0.f, 0.f, 0.f};
                float qnp = 0.f;
#pragma unroll
                for (int ks = 0; ks < 2; ++ks) {
                    float ql[4], qh[4]; unpack4(qa[it][ks][0], ql); unpack4(qa[it][ks][1], qh);
                    const f32x4 nl = *(const LAS f32x4*)(nbuf + D0 + 32 * ks + 4 * q4), nh = *(const LAS f32x4*)(nbuf + D0 + 32 * ks + 16 + 4 * q4);
                    qnp += (ql[0] * nl[0] + ql[1] * nl[1]) + (ql[2] * nl[2] + ql[3] * nl[3]) + (qh[0] * nh[0] + qh[1] * nh[1]) + (qh[2] * nh[2] + qh[3] * nh[3]);
                    const bf16x8 qf = join8(qa[it][ks][0], qa[it][ks][1]);
#pragma unroll
                    for (int dvt = 0; dvt < 4; ++dvt) { const bf16x8 cf = pack8(C[2 * ks][dvt], C[2 * ks + 1][dvt]); P[dvt] = __builtin_amdgcn_mfma_f32_16x16x32_bf16(qf, cf, P[dvt], 0, 0, 0); }
                }
#pragma unroll
                for (int dvt = 0; dvt < 4; ++dvt) red[(w * 16 + it * 4 + dvt) * 64 + lane] = P[dvt];
                qnp += __shfl_xor(qnp, 16); qnp += __shfl_xor(qnp, 32);
                if (q4 == 0) qnred[w * 64 + 16 * it + r] = qnp;
            }
        }
        {
#pragma unroll
            for (int dkt = 0; dkt < 4; ++dkt)
#pragma unroll
                for (int dvt = 0; dvt < 4; ++dvt) C[dkt][dvt] *= decay;
            float npart[4] = {0.f, 0.f, 0.f, 0.f};
#pragma unroll
            for (int ks = 0; ks < 2; ++ks) {
                bf16x8 vw[4];
                const f32x4 wl = *(const LAS f32x4*)(s_wg + 32 * ks + 8 * q4), wh = *(const LAS f32x4*)(s_wg + 32 * ks + 8 * q4 + 4);
#pragma unroll
                for (int dvt = 0; dvt < 4; ++dvt) {
                    float vl[4], vh[4]; unpack4(va[dvt][ks][0], vl); unpack4(va[dvt][ks][1], vh);
                    f32x4 a = {vl[0] * wl[0], vl[1] * wl[1], vl[2] * wl[2], vl[3] * wl[3]}, bb = {vh[0] * wh[0], vh[1] * wh[1], vh[2] * wh[2], vh[3] * wh[3]};
                    vw[dvt] = pack8(a, bb);
                }
#pragma unroll
                for (int dkt = 0; dkt < 4; ++dkt) {
                    float kl[4], kh[4]; unpack4(ka[dkt][ks][0], kl); unpack4(ka[dkt][ks][1], kh);
                    npart[dkt] += (kl[0] * wl[0] + kl[1] * wl[1]) + (kl[2] * wl[2] + kl[3] * wl[3]) + (kh[0] * wh[0] + kh[1] * wh[1]) + (kh[2] * wh[2] + kh[3] * wh[3]);
                    const bf16x8 kf = join8(ka[dkt][ks][0], ka[dkt][ks][1]);
#pragma unroll
                    for (int dvt = 0; dvt < 4; ++dvt) C[dkt][dvt] = __builtin_amdgcn_mfma_f32_16x16x32_bf16(kf, vw[dvt], C[dkt][dvt], 0, 0, 0);
                }
            }
#pragma unroll
            for (int dkt = 0; dkt < 4; ++dkt) { float v = npart[dkt]; v += __shfl_xor(v, 16); v += __shfl_xor(v, 32);
                if (q4 == 0) nbuf[D0 + 16 * dkt + r] = decay * nbuf[D0 + 16 * dkt + r] + v; }
        }
        unsigned pfv = 0u;
        if (c < 31 && tid < 208) pfv = *(const unsigned*)(p.ws + (size_t)(pfoff + (unsigned)(c + 1) * (tid < 192 ? 262144u : 16384u)));
        f32x4 sr[2][2];
#pragma unroll
        for (int ks = 0; ks < 2; ++ks) { const unsigned so = (unsigned)(((bh * 32 + c) * 64 + 16 * it_o + r) * 64 + 32 * ks + 8 * q4) * 4u;
            sr[ks][0] = *(const f32x4*)((const char*)SR + so); sr[ks][1] = *(const f32x4*)((const char*)SR + so + 16u); }
        __syncthreads();
        {
            const int it = it_o;
            f32x4 acc2[2], sv[2] = {{0.f, 0.f, 0.f, 0.f}, {0.f, 0.f, 0.f, 0.f}};
#pragma unroll
            for (int d2 = 0; d2 < 2; ++d2) { const int tile = it * 4 + 2 * (w & 1) + d2; f32x4 a = red[tile * 64 + lane];
#pragma unroll 3
                for (int ww = 1; ww < 8; ++ww) a += red[(ww * 16 + tile) * 64 + lane];
                acc2[d2] = a; }
            float qn[4];
#pragma unroll
            for (int j = 0; j < 4; ++j) { float a = 0.f;
#pragma unroll
                for (int ww = 0; ww < 8; ++ww) a += qnred[ww * 64 + 16 * it + 4 * q4 + j];
                qn[j] = a; }
            const int i = 16 * it + r; const float Mi = s_M[i]; float rowsum = 0.f;
#pragma unroll
            for (int ks = 0; ks < 2; ++ks) {
                const f32x4 s0 = sr[ks][0], s1 = sr[ks][1];
                const f32x4 a0 = *(const LAS f32x4*)(s_a + 32 * ks + 8 * q4), a1 = *(const LAS f32x4*)(s_a + 32 * ks + 8 * q4 + 4);
                f32x4 e0, e1;
#pragma unroll
                for (int j = 0; j < 4; ++j) { const int j0 = 32 * ks + 8 * q4 + j;
                    e0[j] = (j0 <= i) ? s0[j] * QK_SCALE * __expf(a0[j] - Mi) : 0.f; e1[j] = (j0 + 4 <= i) ? s1[j] * QK_SCALE * __expf(a1[j] - Mi) : 0.f;
                    rowsum += e0[j] + e1[j]; }
                const bf16x8 sf = pack8(e0, e1);
#pragma unroll
                for (int d2 = 0; d2 < 2; ++d2) {
                    const u32x2 x0 = (va[d2][ks][0] & ~om) | (va[2 + d2][ks][0] & om), x1 = (va[d2][ks][1] & ~om) | (va[2 + d2][ks][1] & om);
                    sv[d2] = __builtin_amdgcn_mfma_f32_16x16x32_bf16(sf, join8(x0, x1), sv[d2], 0, 0, 0); }
            }
            rowsum += __shfl_xor(rowsum, 16); rowsum += __shfl_xor(rowsum, 32);
            if (q4 == 0) s_rs[r] = rowsum;
            asm volatile("s_waitcnt lgkmcnt(0)" ::: "memory");
            float s1[4] = {0.f, 0.f, 0.f, 0.f}, s2[4] = {0.f, 0.f, 0.f, 0.f};
#pragma unroll
            for (int j = 0; j < 4; ++j) {
                const int ii = 16 * it + 4 * q4 + j; const float wi = s_wi[ii];
                const float den = wi * qn[j] + s_rs[4 * q4 + j]; const float dn = fmaxf(fabsf(den), s_ei[ii]); const float inv = 1.f / dn;
#pragma unroll
                for (int d2 = 0; d2 < 2; ++d2) { const int dvt = 2 * (w & 1) + d2; const float hv = (wi * acc2[d2][j] + sv[d2][j]) * inv;
                    H[(size_t)(T0 + ii) * WD + V0 + 16 * dvt + r] = (bf16_t)f2bf(hv); s1[j] += hv; s2[j] += hv * hv; }
            }
#pragma unroll
            for (int j = 0; j < 4; ++j) {
#pragma unroll
                for (int o = 1; o < 16; o <<= 1) { s1[j] += __shfl_xor(s1[j], o); s2[j] += __shfl_xor(s2[j], o); }
                if (r == 0 && stats) { const int ii = 16 * it + 4 * q4 + j; atomicAdd(hst + ((size_t)(T0 + ii) * 4 + h) * 2, s1[j]); atomicAdd(hst + ((size_t)(T0 + ii) * 4 + h) * 2 + 1, s2[j]); }
            }
        }
        mst = m_next;
        if (pfv == 0x9e3779b9u) ((unsigned*)(p.ws + WS_BAR))[3600] = pfv;
        __syncthreads();
    }
#pragma unroll
    for (int dkt = 0; dkt < 4; ++dkt)
#pragma unroll
        for (int dvt = 0; dvt < 4; ++dvt)
#pragma unroll
            for (int j = 0; j < 4; ++j) p.out[O_CP + ((size_t)bh * 512 + D0 + 16 * dkt + 4 * q4 + j) * 512 + 64 * s + 16 * dvt + r] = C[dkt][dvt][j];
    if (s == 0) { p.out[O_NP + (size_t)bh * 512 + tid] = nbuf[tid]; if (tid == 0) p.out[O_MP + bh] = mst; }
    __syncthreads();
}

DI void mlstm_sample_item(const Params& p, LAS unsigned char* lds, int item, bool stats, const int wv__) {
    const int tid = ltid(), lane = tid & 63, w = tid >> 6;
    int zv = 0; asm volatile("" : "+v"(zv));
    const int bh = item, b = bh >> 2, h = bh & 3, R0 = TP + 8 * b + zv, F0 = 512 * h;
    const bf16_t* Q = (const bf16_t*)(p.ws + WS_Q); const bf16_t* KR = (const bf16_t*)(p.ws + WS_KR); const bf16_t* VT = (const bf16_t*)(p.ws + WS_VT);
    const float* gates = (const float*)(p.ws + WS_ZERO) + Z_GATES; bf16_t* H = (bf16_t*)(p.ws + WS_H); float* hst = (float*)(p.ws + WS_ZERO) + Z_HST;
    LAS float* qs = (LAS float*)lds;
    LAS float* kws = (LAS float*)(lds + 16384);
    LAS float* red = (LAS float*)(lds + 32768);
    LAS float* Sred = (LAS float*)(lds + 98304);
    LAS float* Sm = (LAS float*)(lds + 98304 + 2048);
    LAS float* qnw = (LAS float*)(lds + 98304 + 2304);
    LAS float* hs = (LAS float*)(lds + 98304 + 2560);
    const float m0 = p.st_m[bh + zv];
    float av[8], Mv[8], wi[8], wg[8], ei[8]; float bc = 0.f, cm = -INFINITY;
#pragma unroll
    for (int t = 0; t < 8; ++t) { const float gi = gates[(size_t)(R0 + t) * 8 + h + zv] + p.b_b_if[h + zv], gf = gates[(size_t)(R0 + t) * 8 + 4 + h + zv] + p.b_b_if[4 + h + zv];
        bc += log_sigmoid_f(gf); av[t] = gi - bc; cm = fmaxf(cm, av[t]); Mv[t] = fmaxf(m0, cm); wi[t] = __expf(m0 - Mv[t]); ei[t] = __expf(-(bc + Mv[t])); }
    const float M7 = Mv[7], decay = __expf(m0 - M7), m_new = bc + M7;
#pragma unroll
    for (int t = 0; t < 8; ++t) wg[t] = QK_SCALE * __expf(av[t] - M7);
    { const int i = lane >> 3, jj = lane & 7; const bf16_t* qp = Q + (size_t)(R0 + i) * WD + F0 + 64 * w; const bf16_t* kp = KR + (size_t)(R0 + jj) * WD + F0 + 64 * w; float a = 0.f;
#pragma unroll
        for (int k8 = 0; k8 < 8; ++k8) { float qf[8], kf[8]; unpack8(*(const u32x4*)(qp + 8 * k8), qf); unpack8(*(const u32x4*)(kp + 8 * k8), kf);
#pragma unroll
            for (int e = 0; e < 8; ++e) a += qf[e] * kf[e]; }
        Sred[w * 64 + lane] = a; }
    { const float n0 = p.st_n[(size_t)bh * 512 + tid]; float qv[8], kv[8], ksum = 0.f;
#pragma unroll
        for (int t = 0; t < 8; ++t) { qv[t] = wi[t] * bflo((unsigned)Q[(size_t)(R0 + t) * WD + F0 + tid]); kv[t] = wg[t] * bflo((unsigned)KR[(size_t)(R0 + t) * WD + F0 + tid]); ksum += kv[t]; }
        *(LAS f32x4*)(qs + tid * 8) = (f32x4){qv[0], qv[1], qv[2], qv[3]}; *(LAS f32x4*)(qs + tid * 8 + 4) = (f32x4){qv[4], qv[5], qv[6], qv[7]};
        *(LAS f32x4*)(kws + tid * 8) = (f32x4){kv[0], kv[1], kv[2], kv[3]}; *(LAS f32x4*)(kws + tid * 8 + 4) = (f32x4){kv[4], kv[5], kv[6], kv[7]};
        p.out[O_NS + (size_t)bh * 512 + tid] = decay * n0 + ksum;
#pragma unroll
        for (int t = 0; t < 8; ++t) { const float v = wave_sum(qv[t] * n0); if (lane == 0) qnw[w * 8 + t] = v; } }
    __syncthreads();
    if (tid < 64) { const int i = tid >> 3, jj = tid & 7; float a = 0.f;
#pragma unroll
        for (int ww = 0; ww < 8; ++ww) a += Sred[ww * 64 + tid];
        float avj = av[0], Mi = Mv[0];
#pragma unroll
        for (int t = 1; t < 8; ++t) { if (jj == t) avj = av[t]; if (i == t) Mi = Mv[t]; }
        Sm[tid] = (jj <= i) ? a * QK_SCALE * __expf(avj - Mi) : 0.f; }
    __syncthreads();
    const int dg = tid >> 7, ec = tid & 127, e0 = 4 * ec;
    f32x4 v[8];
#pragma unroll
    for (int tq = 0; tq < 2; ++tq) {
        float vv[4][4];
#pragma unroll
        for (int e = 0; e < 4; ++e) unpack4(*(const u32x2*)(VT + ((size_t)(R0 / 4 + tq) * WD + F0 + e0 + e) * 4), vv[e]);
#pragma unroll
        for (int j = 0; j < 4; ++j) v[4 * tq + j] = (f32x4){vv[0][j], vv[1][j], vv[2][j], vv[3][j]};
    }
    f32x4 num[8];
#pragma unroll
    for (int i = 0; i < 8; ++i) num[i] = (f32x4){0.f, 0.f, 0.f, 0.f};
    const float* C0 = p.st_C + ((size_t)bh * 512) * 512 + e0; float* C1 = p.out + O_CS + ((size_t)bh * 512) * 512 + e0;
#pragma unroll 8
    for (int it = 0; it < 128; ++it) {
        const int d = dg + 4 * it;
        const f32x4 c4 = __builtin_nontemporal_load((const f32x4*)(C0 + (size_t)d * 512));
        const f32x4 q0 = *(const LAS f32x4*)(qs + d * 8), q1 = *(const LAS f32x4*)(qs + d * 8 + 4), k0 = *(const LAS f32x4*)(kws + d * 8), k1 = *(const LAS f32x4*)(kws + d * 8 + 4);
        f32x4 cn = c4 * decay;
#pragma unroll
        for (int i = 0; i < 4; ++i) { num[i] += c4 * q0[i]; num[4 + i] += c4 * q1[i]; cn += v[i] * k0[i]; cn += v[4 + i] * k1[i]; }
        __builtin_nontemporal_store(cn, (f32x4*)(C1 + (size_t)d * 512));
    }
#pragma unroll
    for (int i = 0; i < 8; ++i) *(LAS f32x4*)(red + (dg * 8 + i) * 512 + 4 * ec) = num[i];
    __syncthreads();
    float vc[8];
    { float t0[4], t1[4]; unpack4(*(const u32x2*)(VT + ((size_t)(R0 / 4) * WD + F0 + tid) * 4), t0); unpack4(*(const u32x2*)(VT + ((size_t)(R0 / 4 + 1) * WD + F0 + tid) * 4), t1);
#pragma unroll
      for (int j = 0; j < 4; ++j) { vc[j] = t0[j]; vc[4 + j] = t1[j]; } }
#pragma unroll
    for (int i = 0; i < 8; ++i) {
        float a = (red[(0 * 8 + i) * 512 + tid] + red[(1 * 8 + i) * 512 + tid]) + (red[(2 * 8 + i) * 512 + tid] + red[(3 * 8 + i) * 512 + tid]);
#pragma unroll
        for (int j = 0; j < 8; ++j) a += Sm[i * 8 + j] * vc[j];
        float den = 0.f;
#pragma unroll
        for (int j = 0; j < 8; ++j) den += Sm[i * 8 + j] + qnw[j * 8 + i];
        const float hv = a / fmaxf(fabsf(den), ei[i]);
        H[(size_t)(R0 + i) * WD + F0 + tid] = (bf16_t)f2bf(hv);
        const float s1 = wave_sum(hv), s2 = wave_sum(hv * hv);
        if (lane == 0 && stats) { atomicAdd(hst + ((size_t)(R0 + i) * 4 + h) * 2, s1); atomicAdd(hst + ((size_t)(R0 + i) * 4 + h) * 2 + 1, s2); }
    }
    if (tid == 0) p.out[O_MS + bh] = m_new;
    __syncthreads();
}

DI void outprep_load(const bf16_t* H, const float* hst, const bf16_t* XC, const bf16_t* SZ, int task, float& mu, float& rs, f32x4& h0, f32x4& h1, u32x4& xc, u32x4& sz) {
    const int cg8 = task & 255, row = task >> 8, ch = cg8 * 8, head = ch >> 9;
    mu = hst[((size_t)row * 4 + head) * 2] * (1.f / 512.f); const float var = fmaxf(hst[((size_t)row * 4 + head) * 2 + 1] * (1.f / 512.f) - mu * mu, 0.f);
    rs = rsqrtf(var + 1e-5f);
    { float hf[8]; unpack8(*(const u32x4*)(H + (size_t)row * WD + ch), hf); h0 = (f32x4){hf[0], hf[1], hf[2], hf[3]}; h1 = (f32x4){hf[4], hf[5], hf[6], hf[7]}; }
    xc = *(const u32x4*)(XC + (size_t)row * WD + ch); sz = *(const u32x4*)(SZ + (size_t)row * WD + ch);
}
DI void outprep_store(bf16_t* OB, int task, float mu, float rs, f32x4 h0, f32x4 h1, u32x4 xcp, u32x4 szp, f32x4 o0, f32x4 o1, f32x4 k0, f32x4 k1) {
    const int cg8 = task & 255, row = task >> 8, ch = cg8 * 8;
    float xc[8], sz[8], y[8]; unpack8(xcp, xc); unpack8(szp, sz);
#pragma unroll
    for (int e = 0; e < 4; ++e) { y[e] = ((h0[e] - mu) * rs * o0[e] + k0[e] * xc[e]) * sz[e]; y[4 + e] = ((h1[e] - mu) * rs * o1[e] + k1[e] * xc[4 + e]) * sz[4 + e]; }
    u32x4 o; o.x = pk2(y[0], y[1]); o.y = pk2(y[2], y[3]); o.z = pk2(y[4], y[5]); o.w = pk2(y[6], y[7]);
    *(u32x4*)(OB + (size_t)row * WD + ch) = o;
}
DI void phase_outprep(const Params& p, int G, const int wv__) {
    const bf16_t* H = (const bf16_t*)(p.ws + WS_H); const float* hst = (const float*)(p.ws + WS_ZERO) + Z_HST;
    const bf16_t* XC = (const bf16_t*)(p.ws + WS_XC); const bf16_t* SZ = (const bf16_t*)(p.ws + WS_SZ); bf16_t* OB = (bf16_t*)(p.ws + WS_OB);
    const int ntask = TT * 256, NT = G * 512;
    const int t0 = blockIdx.x * 512 + ltid(), ch = (t0 & 255) * 8;
    const f32x4 o0 = *(const f32x4*)(p.b_onorm_w + ch), o1 = *(const f32x4*)(p.b_onorm_w + ch + 4), k0 = *(const f32x4*)(p.b_skip + ch), k1 = *(const f32x4*)(p.b_skip + ch + 4);
    for (int task = t0; task < ntask; task += 2 * NT) {
        const int task2 = task + NT; const bool has2 = task2 < ntask;
        float muA, rsA, muB, rsB; f32x4 hA0, hA1, hB0, hB1; u32x4 xA, zA, xB, zB;
        outprep_load(H, hst, XC, SZ, task, muA, rsA, hA0, hA1, xA, zA);
        outprep_load(H, hst, XC, SZ, has2 ? task2 : task, muB, rsB, hB0, hB1, xB, zB);
        outprep_store(OB, task, muA, rsA, hA0, hA1, xA, zA, o0, o1, k0, k1);
        if (has2) outprep_store(OB, task2, muB, rsB, hB0, hB1, xB, zB, o0, o1, k0, k1);
    }
}
DI void phase_final(const Params& p, int G, const int wv__) {
    const int lane = ltid() & 63, gw = blockIdx.x * 8 + (ltid() >> 6), NGW = G * 8;
    f32x4 fw[4];
#pragma unroll
    for (int j = 0; j < 4; ++j) fw[j] = *(const f32x4*)(p.final_norm_w + 4 * lane + 256 * j);
    for (int row = gw; row < TT; row += 2 * NGW) {
        const int row2 = row + NGW; const bool has2 = row2 < TT;
        float* y0 = p.out + O_Y + (size_t)row * DM; float* y1 = p.out + O_Y + (size_t)(has2 ? row2 : row) * DM;
        f32x4 v0[4], v1[4]; float s0 = 0.f, s1 = 0.f;
#pragma unroll
        for (int j = 0; j < 4; ++j) { v0[j] = *(const f32x4*)(y0 + 4 * lane + 256 * j); v1[j] = *(const f32x4*)(y1 + 4 * lane + 256 * j); }
#pragma unroll
        for (int j = 0; j < 4; ++j) { s0 += (v0[j][0] * v0[j][0] + v0[j][1] * v0[j][1]) + (v0[j][2] * v0[j][2] + v0[j][3] * v0[j][3]); s1 += (v1[j][0] * v1[j][0] + v1[j][1] * v1[j][1]) + (v1[j][2] * v1[j][2] + v1[j][3] * v1[j][3]); }
        const float r0 = rsqrtf(wave_sum(s0) * (1.f / DM) + 1e-6f), r1 = rsqrtf(wave_sum(s1) * (1.f / DM) + 1e-6f);
#pragma unroll
        for (int j = 0; j < 4; ++j) { *(f32x4*)(y0 + 4 * lane + 256 * j) = v0[j] * r0 * fw[j]; if (has2) *(f32x4*)(y1 + 4 * lane + 256 * j) = v1[j] * r1 * fw[j]; }
    }
}

#define XB_TMO      128
#define XB_XCNT(j)  (256  + 64 * (j))
#define XB_XSUB(j)  (1280 + 64 * (j))
#define XB_XGEN(j)  (2304 + 64 * (j))
#define XB_TOP      3328
#define XB_TOPGEN   3392
#define XCD_BAR_WORDS 3456
#define XB_SPIN_CAP (1u << 18)
DI unsigned xb_ld(unsigned* p)              { return __hip_atomic_load(p, __ATOMIC_RELAXED, __HIP_MEMORY_SCOPE_AGENT); }
DI unsigned xb_add(unsigned* p, unsigned v) { return __hip_atomic_fetch_add(p, v, __ATOMIC_RELAXED, __HIP_MEMORY_SCOPE_AGENT); }
DI unsigned xb_xcc_id() { return (unsigned)__builtin_amdgcn_s_getreg((3 << 11) | 20) & 0xFu; }
#define XB_SPIN(cond, bar) do { unsigned _sp = 0; while (cond) { __builtin_amdgcn_s_sleep(1); \
    if ((++_sp & 255u) == 0u) { if (xb_ld(&(bar)[XB_TMO])) break; if (_sp > XB_SPIN_CAP) { atomicAdd(&(bar)[XB_TMO], 1u); break; } } } } while (0)
DI void xcd_barrier_complete(unsigned* bar, unsigned x, unsigned& nloc, unsigned& nx) {
    const unsigned G = gridDim.x;
    unsigned sum, cnt, mine, sp = 0u;
    for (;;) {
        sum = 0u; cnt = 0u; mine = 0u;
#pragma unroll
        for (unsigned j = 0; j < 16; ++j) { const unsigned c = xb_ld(&bar[XB_XCNT(j)]); sum += c; cnt += (c > 0u) ? 1u : 0u; mine = (j == x) ? c : mine; }
        if (sum == G) break;
        __builtin_amdgcn_s_sleep(1);
        if ((++sp & 255u) == 0u) { if (xb_ld(&bar[XB_TMO])) break; if (sp > XB_SPIN_CAP) { atomicAdd(&bar[XB_TMO], 1u); break; } }
    }
    nloc = mine > 0u ? mine : 1u; nx = cnt > 0u ? cnt : 1u;
}
DI void xcd_barrier(unsigned* bar, volatile LAS unsigned* st, const int wv__) {
    asm volatile("s_waitcnt vmcnt(0)" ::: "memory");
    __syncthreads();
    if (ltid() == 0) {
        const unsigned x = xb_xcc_id();
        __builtin_amdgcn_s_waitcnt(0);
        unsigned nloc = st[0], nx = st[1];
        if (nloc == 0u) { xcd_barrier_complete(bar, x, nloc, nx); st[0] = nloc; st[1] = nx; }
        const unsigned old = xb_add(&bar[XB_XSUB(x)], 1u);
        const unsigned gen = old / nloc;
        if (old + 1u == (gen + 1u) * nloc) {
            __builtin_amdgcn_fence(__ATOMIC_RELEASE, "agent");
            asm volatile("s_waitcnt vmcnt(0)" ::: "memory");
            const unsigned og = xb_add(&bar[XB_TOP], 1u);
            const unsigned tg = og / nx;
            if (og + 1u == (tg + 1u) * nx) xb_add(&bar[XB_TOPGEN], 1u);
            else XB_SPIN(xb_ld(&bar[XB_TOPGEN]) == tg, bar);
            __builtin_amdgcn_fence(__ATOMIC_ACQUIRE, "agent");
            xb_add(&bar[XB_XGEN(x)], 1u);
            asm volatile("s_waitcnt vmcnt(0)" ::: "memory");
        } else {
            XB_SPIN(xb_ld(&bar[XB_XGEN(x)]) == gen, bar);
            __builtin_amdgcn_fence(__ATOMIC_ACQUIRE, "agent");
            asm volatile("s_waitcnt vmcnt(0)" ::: "memory");
        }
    }
    __syncthreads();
}

DI Params load_params() {
    const __attribute__((address_space(4))) unsigned long long* k = (const __attribute__((address_space(4))) unsigned long long*)__builtin_amdgcn_kernarg_segment_ptr();
    asm volatile("" : "+s"(k));
    Params p; unsigned long long* d = (unsigned long long*)&p;
#pragma unroll
    for (int i = 0; i < 25; ++i) d[i] = k[i];
    return p;
}
__global__ void __launch_bounds__(512, 2) fwd_megakernel(Params p_unused) {
    extern __shared__ __attribute__((aligned(16))) unsigned char lds_raw[];
    LAS unsigned char* lds = (LAS unsigned char*)lds_raw;
    cg::grid_group grid = cg::this_grid();
    const int G = gridDim.x, bx = blockIdx.x;
    const int wv__ = __builtin_amdgcn_readfirstlane((int)threadIdx.x >> 6);
    volatile LAS unsigned* bst = (volatile LAS unsigned*)(lds + LDS_BYTES - 64);
    if (ltid() == 0) { bst[0] = 0u; bst[1] = 0u; }
    __syncthreads();

    if (ltid() == 0) (void)xb_add((unsigned*)(load_params().ws + WS_BAR) + XB_XCNT(xb_xcc_id()), 1u);
    { const Params p = load_params(); phase0(p, lds, G, wv__); }
    if (G > 65535) grid.sync();
    xcd_barrier((unsigned*)(load_params().ws + WS_BAR), bst, wv__);
    {
        const Params p = load_params(); unsigned char* ws = p.ws;
        pg8::Gemm g{(const bf16_t*)(ws + WS_XN0), (const bf16_t*)(ws + WS_WAIN), TT, 8192, 1024}; pg8::StaticOrder S; S.init(TT, 8192, G, bx);
        EpiAin E{(bf16_t*)(ws + WS_U), (bf16_t*)(ws + WS_GZ), (bf16_t*)(ws + WS_YA), p.out, p.a_conv_w, p.st_conv_a};
        pg8::gemm_phase<EpiAin, pg8::StaticOrder, true, true>(lds, g, S, E, wv__);
    }
    xcd_barrier((unsigned*)(load_params().ws + WS_BAR), bst, wv__);
    {
        const Params p = load_params(); unsigned char* ws = p.ws; float* zf = (float*)(ws + WS_ZERO);
        pg8::Gemm g{(const bf16_t*)(ws + WS_YA), (const bf16_t*)(ws + WS_WAOUT), TT, 1024, 2048}; pg8::StaticOrder S; S.init(TT, 1024, G, bx);
        { Unit uu; for (int i = 0; S.next(i, uu); ++i) convA_fixup_panel(p, uu.pm, wv__); }
        asm volatile("s_waitcnt vmcnt(0)" ::: "memory"); __syncthreads();
        EpiRes E{p.x_prompt, p.x_sample, TP, (float*)(ws + WS_X1), (bf16_t*)(ws + WS_X1B), zf + Z_SSQ1};
        pg8::gemm_phase<EpiRes, pg8::StaticOrder, true, true>(lds, g, S, E, wv__);
    }
    xcd_barrier((unsigned*)(load_params().ws + WS_BAR), bst, wv__);
    {
        const Params p = load_params(); unsigned char* ws = p.ws; float* zf = (float*)(ws + WS_ZERO);
        pg8::Gemm g{(const bf16_t*)(ws + WS_X1B), (const bf16_t*)(ws + WS_WBIN), TT, 4096, 1024}; pg8::StaticOrder S; S.init(TT, 4096, G, bx);
        EpiBin E{zf + Z_SSQ1, (bf16_t*)(ws + WS_XM), (bf16_t*)(ws + WS_SZ), p.out};
        pg8::gemm_phase<EpiBin, pg8::StaticOrder, true, true>(lds, g, S, E, wv__);
    }
    xcd_barrier((unsigned*)(load_params().ws + WS_BAR), bst, wv__);
    { const Params p = load_params(); phase_convB8(p, G, wv__); }
    xcd_barrier((unsigned*)(load_params().ws + WS_BAR), bst, wv__);
    {
        const Params p = load_params(); unsigned char* ws = p.ws; float* gates = (float*)(ws + WS_ZERO) + Z_GATES;
        pg8::StaticOrder Sq, Sk, Sv; Sq.init(TT, 2304, G, bx); Sk.init(TT, 2048, G, (bx + G - 104) % G); Sv.init(TT, 2304, G, (bx + G - 136) % G);
        { pg8::Gemm g{(const bf16_t*)(ws + WS_XC), (const bf16_t*)(ws + WS_WQ), TT, 2304, 2048};
          EpiQ E{(bf16_t*)(ws + WS_Q), gates}; pg8::gemm_phase<EpiQ, pg8::StaticOrder, true, true>(lds, g, Sq, E, wv__); }
        { pg8::Gemm g{(const bf16_t*)(ws + WS_XC), (const bf16_t*)(ws + WS_WK), TT, 2048, 2048};
          EpiKV E{(bf16_t*)(ws + WS_KT), (bf16_t*)(ws + WS_KR), nullptr}; pg8::gemm_phase<EpiKV, pg8::StaticOrder, true, true>(lds, g, Sk, E, wv__); }
        { pg8::Gemm g{(const bf16_t*)(ws + WS_XM), (const bf16_t*)(ws + WS_WV), TT, 2304, 2048};
          EpiKV E{(bf16_t*)(ws + WS_VT), nullptr, gates}; pg8::gemm_phase<EpiKV, pg8::StaticOrder, true, true>(lds, g, Sv, E, wv__); }
    }
    xcd_barrier((unsigned*)(load_params().ws + WS_BAR), bst, wv__);
    { const Params p = load_params(); phase_sraw(p, G, wv__); }
    xcd_barrier((unsigned*)(load_params().ws + WS_BAR), bst, wv__);
    {
        const Params p = load_params();
        for (int i = bx; i < 256; i += G) { const int item = (G == 256) ? (((i & 7) * 4 + (i >> 6)) * 8 + ((i >> 3) & 7)) : i; mlstm_prompt_item(p, lds, item, true, wv__); }
    }
    { const Params p = load_params(); for (int item = bx; item < 512; item += G) mlstm_sample_item(p, lds, item, true, wv__); }
    xcd_barrier((unsigned*)(load_params().ws + WS_BAR), bst, wv__);
    { const Params p = load_params(); phase_outprep(p, G, wv__); }
    xcd_barrier((unsigned*)(load_params().ws + WS_BAR), bst, wv__);
    {
        const Params p = load_params(); unsigned char* ws = p.ws; float* zf = (float*)(ws + WS_ZERO);
        {
            pg8::Gemm g{(const bf16_t*)(ws + WS_OB), (const bf16_t*)(ws + WS_WBOUT), TT, 1024, 2048}; pg8::StaticOrder S; S.init(TT, 1024, G, bx);
            EpiRes E{(const float*)(ws + WS_X1), (const float*)(ws + WS_X1), TT, p.out + O_Y, nullptr, nullptr};
            pg8::gemm_phase<EpiRes, pg8::StaticOrder, true, true>(lds, g, S, E, wv__);
        }
    }
    xcd_barrier((unsigned*)(load_params().ws + WS_BAR), bst, wv__);
    { const Params p = load_params(); phase_final(p, G, wv__); }
}

extern "C" void kernel_launch(void* const* d_in, const int* in_sizes, int n_in, void* d_out, int out_size, void* d_ws, size_t ws_size, hipStream_t stream) {
    static int grid = 0;
    if (grid == 0) {
        if (n_in != 23 || ws_size < WS_END) { fprintf(stderr, "kernel_launch: unexpected n_in %d / ws %zu (need %zu)\n", n_in, ws_size, (size_t)WS_END); grid = -1; return; }
        int dev = 0, cus = 0, per_cu = 0;
        (void)hipGetDevice(&dev);
        (void)hipDeviceGetAttribute(&cus, hipDeviceAttributeMultiprocessorCount, dev);
        (void)hipFuncSetAttribute((const void*)fwd_megakernel, hipFuncAttributeMaxDynamicSharedMemorySize, LDS_BYTES);
        (void)hipOccupancyMaxActiveBlocksPerMultiprocessor(&per_cu, (const void*)fwd_megakernel, 512, LDS_BYTES);
        if (per_cu < 1) { fprintf(stderr, "kernel_launch: occupancy query says %d blocks/CU\n", per_cu); }
        grid = cus;
    }
    if (grid < 0) return;
    Params p{};
    const float** pp = (const float**)&p;
    for (int i = 0; i < 23; ++i) pp[i] = (const float*)d_in[i];
    p.out = (float*)d_out; p.ws = (unsigned char*)d_ws;
    void* args[] = {&p};
    (void)hipMemsetAsync((char*)d_ws + WS_BAR, 0, 16384, stream);
    hipError_t e = hipLaunchCooperativeKernel((void*)fwd_megakernel, dim3(grid), dim3(512), args, LDS_BYTES, stream);
    if (e != hipSuccess) fprintf(stderr, "cooperative launch failed: %s (grid %d)\n", hipGetErrorString(e), grid);
}
```

```cpp
#include <hip/hip_runtime.h>
#include <hip/hip_cooperative_groups.h>
#include <cstdio>
#include <cstdint>
namespace cg = cooperative_groups;

#define DI __device__ __forceinline__
#define LAS __attribute__((address_space(3)))
typedef unsigned short bf16_t;
typedef short bf16x8 __attribute__((ext_vector_type(8)));
typedef float f32x4 __attribute__((ext_vector_type(4)));
typedef unsigned u32x4 __attribute__((ext_vector_type(4)));
typedef unsigned u32x2 __attribute__((ext_vector_type(2)));

constexpr int DM = 1024, WD = 2048, TP = 16384, TSM = 1024, TT = TP + TSM;
constexpr int NHD = 4, DKH = 512;
constexpr float QK_SCALE = 0.04419417382415922f;
constexpr size_t O_Y = 0, O_CAP = 17825792, O_CAS = 17858560, O_CBP = 18382848, O_CBS = 18432000, O_CP = 19218432, O_CS = 27607040,
                 O_NP = 161824768, O_NS = 161841152, O_MP = 162103296, O_MS = 162103328;
constexpr size_t SZ_A1 = (size_t)TT * DM * 2, SZ_A2 = (size_t)TT * WD * 2;
constexpr size_t WS_WAIN = 0;
constexpr size_t WS_WAOUT = WS_WAIN + (size_t)8192 * 1024 * 2;
constexpr size_t WS_WBIN = WS_WAOUT + (size_t)1024 * 2048 * 2;
constexpr size_t WS_WQ = WS_WBIN + (size_t)4096 * 1024 * 2;
constexpr size_t WS_WK = WS_WQ + (size_t)2304 * 2048 * 2;
constexpr size_t WS_WV = WS_WK + (size_t)2048 * 2048 * 2;
constexpr size_t WS_WBOUT = WS_WV + (size_t)2304 * 2048 * 2;
constexpr size_t WS_WG = WS_WBOUT + (size_t)1024 * 2048 * 2;
constexpr size_t WS_ZERO = WS_WG + (size_t)2 * 2048 * 8 * 4;
constexpr size_t Z_GATES = 0, Z_SSQ1 = (size_t)TT * 8, Z_SSQ2 = Z_SSQ1 + TT, Z_HST = Z_SSQ2 + TT, Z_END = Z_HST + (size_t)TT * 8;
constexpr size_t WS_XN0 = WS_ZERO + ((Z_END * 4 + 255) & ~(size_t)255);
constexpr size_t WS_X1B = WS_XN0 + SZ_A1;
constexpr size_t WS_U = WS_X1B + SZ_A1;
constexpr size_t WS_GZ = WS_U + SZ_A2;
constexpr size_t WS_YA = WS_GZ + SZ_A2;
constexpr size_t WS_XM = WS_YA + SZ_A2;
constexpr size_t WS_SZ = WS_XM + SZ_A2;
constexpr size_t WS_XC = WS_SZ + SZ_A2;
constexpr size_t WS_Q = WS_XC + SZ_A2;
constexpr size_t WS_KR = WS_Q + SZ_A2;
constexpr size_t WS_KT = WS_KR + SZ_A2;
constexpr size_t WS_VT = WS_KT + SZ_A2;
constexpr size_t WS_OB = WS_VT + SZ_A2;
constexpr size_t WS_X1 = WS_OB + SZ_A2;
constexpr size_t WS_H = WS_X1 + (size_t)TT * DM * 4;
constexpr size_t WS_SRAW = WS_H + (size_t)TT * WD * 4;
constexpr size_t WS_BAR = WS_SRAW + (size_t)1024 * 4096 * 4;
constexpr size_t WS_SC = WS_BAR + 16384;
constexpr size_t WS_END = WS_SC + (size_t)1024 * 64 * 16;
constexpr int LDS_BYTES = 155648;

struct Params {
    const float *x_prompt, *x_sample, *st_conv_a, *st_conv_b, *st_C, *st_n, *st_m, *norm_w, *final_norm_w, *a_w_in, *a_conv_w, *a_w_out,
        *b_w_in, *b_conv_w, *b_conv_b, *b_w_q, *b_w_k, *b_w_v, *b_w_if, *b_b_if, *b_skip, *b_onorm_w, *b_w_out;
    float* out; unsigned char* ws;
};

DI int ltid_(int wv) { int t = wv * 64 + (int)__builtin_amdgcn_mbcnt_hi(~0u, __builtin_amdgcn_mbcnt_lo(~0u, 0u)); asm volatile("" : "+v"(t)); return t; }
#define ltid() ltid_(wv__)
DI unsigned cvt_pk_bf16(float lo, float hi) { unsigned r; asm volatile("v_cvt_pk_bf16_f32 %0, %1, %2" : "=v"(r) : "v"(lo), "v"(hi)); return r; }
DI unsigned f2bf(float f) { unsigned u = __builtin_bit_cast(unsigned, f); return (u + 0x7fffu + ((u >> 16) & 1u)) >> 16; }
DI unsigned pk2(float lo, float hi) { return f2bf(lo) | (f2bf(hi) << 16); }
DI float bflo(unsigned u) { return __uint_as_float(u << 16); }
DI float bfhi(unsigned u) { return __uint_as_float(u & 0xffff0000u); }
DI float silu_f(float x) { return x / (1.f + __expf(-x)); }
DI float log_sigmoid_f(float x) { return fminf(x, 0.f) - log1pf(__expf(-fabsf(x))); }
DI float wave_sum(float v) {
#pragma unroll
    for (int o = 1; o < 64; o <<= 1) v += __shfl_xor(v, o);
    return v;
}
DI void unpack8(u32x4 v, float (&f)[8]) { f[0] = bflo(v.x); f[1] = bfhi(v.x); f[2] = bflo(v.y); f[3] = bfhi(v.y); f[4] = bflo(v.z); f[5] = bfhi(v.z); f[6] = bflo(v.w); f[7] = bfhi(v.w); }
DI void unpack4(u32x2 v, float (&f)[4]) { f[0] = bflo(v.x); f[1] = bfhi(v.x); f[2] = bflo(v.y); f[3] = bfhi(v.y); }

namespace pg8 {
constexpr int BM = 256, BK = 64, HALF = 128, HTB = HALF * BK * 2, STAGE_BYTES = 8 * HTB, NXCD = 8, WGM = 8;
__host__ __device__ __forceinline__ int lds_byte(int r, int c) { const int st = (r >> 4) * 2 + (c >> 5), rr = r & 15, cc = c & 31, ob = rr * 64 + cc * 2; return st * 1024 + (ob ^ (((ob >> 9) & 1) << 5)); }
__host__ __device__ __forceinline__ void stage_rc(int b, int& R, int& C) { const int st = b / 1024, sb = b % 1024, swz = sb ^ (((sb >> 9) & 1) << 5); R = (st >> 1) * 16 + swz / 64; C = (st & 1) * 32 + (swz % 64) / 2; }
__host__ __device__ __forceinline__ int perm32(int rho) { const int n = rho >> 4, i = rho & 15; return 8 * (i >> 2) + 4 * n + (i & 3); }
struct Unit { int pm, pn; };
struct Gemm { const bf16_t* A; const bf16_t* Bt; int M, N, K; int ld = 0; };
struct StaticOrder {
    int nM, nN, nwg, G, c;
    __host__ __device__ __forceinline__ void init(int M, int N, int G_, int c_) { nM = M / BM; nN = N / BM; nwg = nM * nN; G = G_; c = c_; }
    __host__ __device__ __forceinline__ bool next(int i, Unit& u) const {
        const long L = (long)i * G + c; if (L >= nwg) return false;
        int wgid = (int)L; { const int q = nwg / NXCD, r = nwg % NXCD, xcd = wgid % NXCD, off = wgid / NXCD; wgid = (xcd < r ? xcd * (q + 1) : r * (q + 1) + (xcd - r) * q) + off; }
        const int nig = WGM * nN, gid = wgid / nig, fm = gid * WGM, gsz = (nM - fm) < WGM ? (nM - fm) : WGM;
        u.pm = fm + ((wgid % nig) % gsz); u.pn = (wgid % nig) / gsz; return true;
    }
    __device__ __forceinline__ void a_ready(const Unit&) const {}
    __device__ __forceinline__ void done(const Unit&) const {}
};

template <class Epi, class Sched, bool ALIGN_EPI = false, bool SP2 = false>
__device__ __forceinline__ void gemm_phase(LAS unsigned char* lds, const Gemm g, const Sched& S, const Epi& E, const int wv__) {
    const int tid = ltid(), wid = __builtin_amdgcn_readfirstlane(tid >> 6), lane = tid & 63, wr = wid >> 2, wc = wid & 3, fr = lane & 15, fq = lane >> 4;
    const int K = g.K, nt = K / BK, ld = g.ld ? g.ld : g.K;
    unsigned voffA[2], voffB[2];
#pragma unroll
    for (int i = 0; i < 2; ++i) { int R, C; stage_rc(tid * 16 + i * 8192, R, C); const int Rb = Epi::PERM ? ((R & ~31) + perm32(R & 31)) : R;
        voffA[i] = (unsigned)(R * ld + C) * 2u; voffB[i] = (unsigned)(Rb * ld + C) * 2u; }
    const size_t kstep = (size_t)(BK * 2);
    const size_t hstep = (size_t)HALF * ld * 2;
    const size_t tstep = 2 * hstep;
    const unsigned ldsw = (unsigned)wid * 1024u;
    const int aoff = lds_byte(wr * 64 + fr, fq * 8), boff = lds_byte(wc * 32 + fr, fq * 8);
#define PG8_SA(b, h) (((b) * 2 + (h)) * HTB)
#define PG8_SB(b, h) ((4 + (b) * 2 + (h)) * HTB)
#define PG8_STAGE(bufoff, gbase, voff) do { _Pragma("unroll") for (int _i = 0; _i < 2; ++_i) \
        __builtin_amdgcn_global_load_lds((const unsigned*)((const char*)(gbase) + (voff)[_i]), (LAS unsigned*)(lds + (bufoff) + ldsw + _i * 8192), 16, 0, 0); } while (0)
#define PG8_LDA(dst, b, h) do { _Pragma("unroll") for (int m = 0; m < 4; ++m) _Pragma("unroll") for (int k = 0; k < 2; ++k) dst[m][k] = *(const LAS bf16x8*)(lds + PG8_SA(b, h) + aoff + m * 2048 + k * 1024); } while (0)
#define PG8_LDB(dst, b, h) do { _Pragma("unroll") for (int n = 0; n < 2; ++n) _Pragma("unroll") for (int k = 0; k < 2; ++k) dst[n][k] = *(const LAS bf16x8*)(lds + PG8_SB(b, h) + boff + n * 2048 + k * 1024); } while (0)
#define PG8_MMA(ai, bj, At, Bt) do { __builtin_amdgcn_s_setprio(1); _Pragma("unroll") for (int m = 0; m < 4; ++m) _Pragma("unroll") for (int n = 0; n < 2; ++n) _Pragma("unroll") for (int k = 0; k < 2; ++k) \
        acc[ai][bj][m][n] = Epi::NORMAL ? __builtin_amdgcn_mfma_f32_16x16x32_bf16(At[m][k], Bt[n][k], acc[ai][bj][m][n], 0, 0, 0) \
                                        : __builtin_amdgcn_mfma_f32_16x16x32_bf16(Bt[n][k], At[m][k], acc[ai][bj][m][n], 0, 0, 0); __builtin_amdgcn_s_setprio(0); } while (0)
#define PG8_WAIT_V(n) asm volatile("s_waitcnt vmcnt(" #n ")" ::: "memory")
#define PG8_WAIT_L(n) asm volatile("s_waitcnt lgkmcnt(" #n ")" ::: "memory")
#define PG8_BAR __builtin_amdgcn_s_barrier()
#define PG8_SCHED __builtin_amdgcn_sched_barrier(0)
    Unit cur, nxt; int ui = 0;
    if (!S.next(0, cur)) return;
    f32x4 acc[2][2][4][2];
#pragma unroll
    for (int a = 0; a < 2; ++a)
#pragma unroll
        for (int b = 0; b < 2; ++b)
#pragma unroll
            for (int m = 0; m < 4; ++m)
#pragma unroll
                for (int n = 0; n < 2; ++n) acc[a][b][m][n] = (f32x4){0.f, 0.f, 0.f, 0.f};
    bf16x8 At[4][2], B0[2][2], B1[2][2];
    const char* cA = (const char*)g.A + (size_t)cur.pm * tstep; const char* cB = (const char*)g.Bt + (size_t)cur.pn * tstep;
    S.a_ready(cur);
    if constexpr (SP2) {
        PG8_STAGE(PG8_SB(0, 0), cB, voffB); PG8_STAGE(PG8_SB(0, 1), cB + hstep, voffB); PG8_STAGE(PG8_SA(0, 0), cA, voffA); PG8_STAGE(PG8_SA(0, 1), cA + hstep, voffA);
        if (wr == 1) PG8_BAR;
        PG8_WAIT_V(2); PG8_BAR;
        PG8_STAGE(PG8_SB(1, 0), cB + kstep, voffB); PG8_STAGE(PG8_SA(1, 0), cA + kstep, voffA); PG8_STAGE(PG8_SB(1, 1), cB + hstep + kstep, voffB);
        PG8_WAIT_V(6); PG8_BAR;
    } else {
        PG8_STAGE(PG8_SB(0, 0), cB, voffB); PG8_STAGE(PG8_SA(0, 0), cA, voffA); PG8_STAGE(PG8_SB(0, 1), cB + hstep, voffB); PG8_STAGE(PG8_SA(0, 1), cA + hstep, voffA);
        if (wr == 1) PG8_BAR;
        PG8_WAIT_V(4); PG8_BAR;
        PG8_STAGE(PG8_SB(1, 0), cB + kstep, voffB); PG8_STAGE(PG8_SA(1, 0), cA + kstep, voffA); PG8_STAGE(PG8_SB(1, 1), cB + hstep + kstep, voffB);
        PG8_WAIT_V(6); PG8_BAR;
    }
    for (;;) {
        const bool has_next = S.next(ui + 1, nxt);
        const char* nA = has_next ? (const char*)g.A + (size_t)nxt.pm * tstep : cA; const char* nB = has_next ? (const char*)g.Bt + (size_t)nxt.pn * tstep : cB;
        for (int t = 0; t < nt; t += 2) {
            const bool last = (t == nt - 2);
            const char* a1 = cA + (size_t)(t + 1) * kstep;
            const char* a2 = last ? nA : cA + (size_t)(t + 2) * kstep; const char* b2 = last ? nB : cB + (size_t)(t + 2) * kstep;
            const char* a3 = a2 + kstep; const char* b3 = b2 + kstep;
            if (last && has_next) S.a_ready(nxt);
            if constexpr (SP2) {
            PG8_LDB(B0, 0, 0); PG8_LDB(B1, 0, 1); PG8_SCHED; PG8_LDA(At, 0, 0); PG8_STAGE(PG8_SA(1, 1), a1 + hstep, voffA);
            PG8_WAIT_V(8); PG8_WAIT_L(0); PG8_BAR; PG8_MMA(0, 0, At, B0); PG8_MMA(0, 1, At, B1); PG8_BAR; PG8_SCHED;
            PG8_LDA(At, 0, 1); PG8_STAGE(PG8_SB(0, 0), b2, voffB); PG8_STAGE(PG8_SB(0, 1), b2 + hstep, voffB); PG8_STAGE(PG8_SA(0, 0), a2, voffA);
            PG8_WAIT_V(8); PG8_WAIT_L(0); PG8_BAR; PG8_MMA(1, 0, At, B0); PG8_MMA(1, 1, At, B1); PG8_BAR; PG8_SCHED;
            PG8_LDB(B0, 1, 0); PG8_LDB(B1, 1, 1); PG8_SCHED; PG8_LDA(At, 1, 0); PG8_STAGE(PG8_SA(0, 1), a2 + hstep, voffA);
            PG8_WAIT_V(8); PG8_WAIT_L(0); PG8_BAR; PG8_MMA(0, 0, At, B0); PG8_MMA(0, 1, At, B1); PG8_BAR; PG8_SCHED;
            PG8_LDA(At, 1, 1); PG8_STAGE(PG8_SB(1, 0), b3, voffB); PG8_STAGE(PG8_SB(1, 1), b3 + hstep, voffB); PG8_STAGE(PG8_SA(1, 0), a3, voffA);
            PG8_WAIT_V(8); PG8_WAIT_L(0); PG8_BAR; PG8_MMA(1, 0, At, B0); PG8_MMA(1, 1, At, B1); PG8_BAR; PG8_SCHED;
            } else {
            PG8_LDB(B0, 0, 0); PG8_SCHED; PG8_LDA(At, 0, 0); PG8_STAGE(PG8_SA(1, 1), a1 + hstep, voffA);
            PG8_WAIT_L(8); PG8_BAR; PG8_WAIT_L(0); PG8_MMA(0, 0, At, B0); PG8_BAR; PG8_SCHED;
            PG8_LDB(B1, 0, 1); PG8_STAGE(PG8_SB(0, 0), b2, voffB);
            PG8_BAR; PG8_WAIT_L(0); PG8_MMA(0, 1, At, B1); PG8_BAR;
            PG8_LDA(At, 0, 1); PG8_STAGE(PG8_SA(0, 0), a2, voffA);
            PG8_BAR; PG8_WAIT_L(0); PG8_MMA(1, 0, At, B0); PG8_BAR; PG8_SCHED;
            PG8_STAGE(PG8_SB(0, 1), b2 + hstep, voffB);
            PG8_WAIT_V(6); PG8_BAR; PG8_MMA(1, 1, At, B1); PG8_BAR;
            PG8_LDB(B0, 1, 0); PG8_SCHED; PG8_LDA(At, 1, 0); PG8_STAGE(PG8_SA(0, 1), a2 + hstep, voffA);
            PG8_WAIT_L(8); PG8_BAR; PG8_WAIT_L(0); PG8_MMA(0, 0, At, B0); PG8_BAR; PG8_SCHED;
            PG8_LDB(B1, 1, 1); PG8_STAGE(PG8_SB(1, 0), b3, voffB);
            PG8_BAR; PG8_WAIT_L(0); PG8_MMA(0, 1, At, B1); PG8_BAR;
            PG8_LDA(At, 1, 1); PG8_STAGE(PG8_SA(1, 0), a3, voffA);
            PG8_BAR; PG8_WAIT_L(0); PG8_MMA(1, 0, At, B0); PG8_BAR; PG8_SCHED;
            PG8_STAGE(PG8_SB(1, 1), b3 + hstep, voffB);
            PG8_WAIT_V(6); PG8_BAR; PG8_MMA(1, 1, At, B1); PG8_BAR;
            }
        }
        if constexpr (ALIGN_EPI) { if (wr == 0) PG8_BAR; }
        E(acc, cur, wr, wc, fr, fq); S.done(cur);
        if (!has_next) break;
#pragma unroll
        for (int a = 0; a < 2; ++a)
#pragma unroll
            for (int b = 0; b < 2; ++b)
#pragma unroll
                for (int m = 0; m < 4; ++m)
#pragma unroll
                    for (int n = 0; n < 2; ++n) acc[a][b][m][n] = (f32x4){0.f, 0.f, 0.f, 0.f};
        cur = nxt; cA = nA; cB = nB; ++ui;
        if constexpr (ALIGN_EPI) { if (wr == 1) PG8_BAR; }
    }
    PG8_WAIT_V(0);
    if constexpr (!ALIGN_EPI) { if (wr == 0) PG8_BAR; }
    PG8_BAR;
#undef PG8_SA
#undef PG8_SB
#undef PG8_STAGE
#undef PG8_LDA
#undef PG8_LDB
#undef PG8_MMA
#undef PG8_WAIT_V
#undef PG8_WAIT_L
#undef PG8_BAR
#undef PG8_SCHED
}
}
using pg8::Unit;

struct EpiAin {
    static constexpr bool PERM = false, AFTER_DRAIN = false, NORMAL = false;
    bf16_t* U; bf16_t* GZ; bf16_t* YA; float* out; const float* cw; const float* sca;
    DI void operator()(const f32x4 (&acc)[2][2][4][2], const Unit& u, int wr, int wc, int fr, int fq) const {
        const int ch0 = u.pn * 64 + wc * 16 + fq * 4, lane = fq * 16 + fr;
        const f32x4 w0 = *(const f32x4*)(cw + ch0), w1 = *(const f32x4*)(cw + WD + ch0), w2 = *(const f32x4*)(cw + 2 * WD + ch0);
#pragma unroll
        for (int ai = 0; ai < 2; ++ai) {
            f32x4 prev = {0.f, 0.f, 0.f, 0.f};
#pragma unroll
            for (int m = 0; m < 4; ++m) {
                const int row = u.pm * 256 + ai * 128 + wr * 64 + m * 16 + fr;
                const f32x4 b = acc[ai][0][m][0], c = acc[ai][0][m][1], xa = acc[ai][1][m][0], z = acc[ai][1][m][1];
                const f32x4 uu = c * xa; f32x4 gz, u1, u2;
#pragma unroll
                for (int e = 0; e < 4; ++e) {
                    gz[e] = b[e] * silu_f(z[e]);
                    const float c1 = __shfl(uu[e], lane - 1), c2 = __shfl(uu[e], lane - 2), p1 = __shfl(prev[e], (lane & 48) + 15), p2 = __shfl(prev[e], (lane & 48) + 14);
                    u1[e] = fr >= 1 ? c1 : p1; u2[e] = fr >= 2 ? c2 : (fr == 1 ? p1 : p2);
                }
                bool valid = true; float* dst = nullptr;
                if (row >= TP) {
                    const int t = row & 7, bb = (row - TP) >> 3;
                    if (t < 2) { const f32x4 b1 = *(const f32x4*)(sca + (size_t)(bb * 2 + 1) * WD + ch0);
                        if (t == 0) { u1 = b1; u2 = *(const f32x4*)(sca + (size_t)(bb * 2) * WD + ch0); } else u2 = b1; }
                    if (t >= 6) dst = out + O_CAS + (size_t)(bb * 2 + (t - 6)) * WD;
                } else {
                    const int t = row & 2047;
                    if (t == 0) { u1 = (f32x4){0.f, 0.f, 0.f, 0.f}; u2 = u1; } else if (t == 1) u2 = (f32x4){0.f, 0.f, 0.f, 0.f}; else if (m == 0 && fr < 2) valid = false;
                    if (t >= 2046) dst = out + O_CAP + (size_t)((row >> 11) * 2 + (t - 2046)) * WD;
                    u32x2 pk; pk.x = cvt_pk_bf16(uu[0], uu[1]); pk.y = cvt_pk_bf16(uu[2], uu[3]);
                    if ((m == 3 && fr >= 14) || (m == 0 && fr < 2)) *(u32x2*)(U + (size_t)row * WD + ch0) = pk;
                    if (m == 0 && fr < 2) { u32x2 pg; pg.x = cvt_pk_bf16(gz[0], gz[1]); pg.y = cvt_pk_bf16(gz[2], gz[3]); *(u32x2*)(GZ + (size_t)row * WD + ch0) = pg; }
                }
                if (valid) { const f32x4 y = gz * (w0 * u2 + w1 * u1 + w2 * uu); u32x2 py; py.x = cvt_pk_bf16(y[0], y[1]); py.y = cvt_pk_bf16(y[2], y[3]); *(u32x2*)(YA + (size_t)row * WD + ch0) = py; }
                if (dst) *(f32x4*)(dst + ch0) = uu;
                prev = uu;
            }
        }
    }
};
DI void convA_fixup_panel(const Params& p, int pm, const int wv__) {
    if (pm >= TP / 256) return;
    const bf16_t* U = (const bf16_t*)(p.ws + WS_U); const bf16_t* GZ = (const bf16_t*)(p.ws + WS_GZ); bf16_t* YA = (bf16_t*)(p.ws + WS_YA);
    const int ch = 4 * ltid();
    const f32x4 w0 = *(const f32x4*)(p.a_conv_w + ch), w1 = *(const f32x4*)(p.a_conv_w + WD + ch), w2 = *(const f32x4*)(p.a_conv_w + 2 * WD + ch);
#pragma unroll
    for (int k = 0; k < 4; ++k) {
        const int r0 = pm * 256 + 64 * k;
        if ((r0 & 2047) == 0) continue;
        float um2[4], um1[4], u0[4], u1[4], g0[4], g1[4];
        unpack4(*(const u32x2*)(U + (size_t)(r0 - 2) * WD + ch), um2); unpack4(*(const u32x2*)(U + (size_t)(r0 - 1) * WD + ch), um1);
        unpack4(*(const u32x2*)(U + (size_t)r0 * WD + ch), u0); unpack4(*(const u32x2*)(U + (size_t)(r0 + 1) * WD + ch), u1);
        unpack4(*(const u32x2*)(GZ + (size_t)r0 * WD + ch), g0); unpack4(*(const u32x2*)(GZ + (size_t)(r0 + 1) * WD + ch), g1);
        float y0[4], y1[4];
#pragma unroll
        for (int e = 0; e < 4; ++e) { y0[e] = g0[e] * (w0[e] * um2[e] + w1[e] * um1[e] + w2[e] * u0[e]); y1[e] = g1[e] * (w0[e] * um1[e] + w1[e] * u0[e] + w2[e] * u1[e]); }
        u32x2 a; a.x = pk2(y0[0], y0[1]); a.y = pk2(y0[2], y0[3]); u32x2 bq; bq.x = pk2(y1[0], y1[1]); bq.y = pk2(y1[2], y1[3]);
        *(u32x2*)(YA + (size_t)r0 * WD + ch) = a; *(u32x2*)(YA + (size_t)(r0 + 1) * WD + ch) = bq;
    }
}
struct EpiRes {
    static constexpr bool PERM = false, AFTER_DRAIN = false, NORMAL = false;
    const float* xa; const float* xb; int split; float* xo; bf16_t* xob; float* ssq;
    DI void operator()(const f32x4 (&acc)[2][2][4][2], const Unit& u, int wr, int wc, int fr, int fq) const {
        const int col0 = u.pn * 256 + wc * 32 + 4 * fq;
#pragma unroll
        for (int ai = 0; ai < 2; ++ai)
#pragma unroll
            for (int m = 0; m < 4; ++m) {
                const int row = u.pm * 256 + ai * 128 + wr * 64 + m * 16 + fr;
                const float* xr = row < split ? xa + (size_t)row * DM : xb + (size_t)(row - split) * DM;
                float s = 0.f;
#pragma unroll
                for (int bj = 0; bj < 2; ++bj)
#pragma unroll
                    for (int n = 0; n < 2; ++n) {
                        const int c = col0 + bj * 128 + n * 16;
                        const f32x4 v = *(const f32x4*)(xr + c) + acc[ai][bj][m][n];
                        *(f32x4*)(xo + (size_t)row * DM + c) = v;
                        if (xob) { u32x2 w; w.x = cvt_pk_bf16(v[0], v[1]); w.y = cvt_pk_bf16(v[2], v[3]); *(u32x2*)(xob + (size_t)row * DM + c) = w; }
                        s += (v[0] * v[0] + v[1] * v[1]) + (v[2] * v[2] + v[3] * v[3]);
                    }
                s += __shfl_xor(s, 16); s += __shfl_xor(s, 32);
                if (fq == 0 && ssq) atomicAdd(ssq + row, s);
            }
    }
};
struct PanelOrder {
    int c;
    DI bool next(int i, Unit& u) const { if (i > 0 || c >= 256) return false; const int x = c & 7, j = c >> 3; u.pm = x * 8 + (j >> 2); u.pn = j & 3; return true; }
    DI void a_ready(const Unit&) const {}
    DI void done(const Unit&) const {}
};
struct SliceOrder {
    int c;
    DI bool next(int i, Unit& u) const { if (i > 0 || c >= 128) return false; const int ui = c & 15; u.pm = 64 + (ui >> 2); u.pn = ui & 3; return true; }
    DI void a_ready(const Unit&) const {}
    DI void done(const Unit&) const {}
};
struct EpiResAtomic {
    static constexpr bool PERM = false, AFTER_DRAIN = false, NORMAL = false;
    const float* xin; float* xo; int add_res;
    DI void operator()(const f32x4 (&acc)[2][2][4][2], const Unit& u, int wr, int wc, int fr, int fq) const {
        const int col0 = u.pn * 256 + wc * 32 + 4 * fq;
#pragma unroll
        for (int ai = 0; ai < 2; ++ai)
#pragma unroll
            for (int m = 0; m < 4; ++m) {
                const int row = u.pm * 256 + ai * 128 + wr * 64 + m * 16 + fr;
#pragma unroll
                for (int bj = 0; bj < 2; ++bj)
#pragma unroll
                    for (int n = 0; n < 2; ++n) {
                        const int c = col0 + bj * 128 + n * 16; f32x4 v = acc[ai][bj][m][n];
                        if (add_res) v += *(const f32x4*)(xin + (size_t)row * DM + c);
                        float* o = xo + (size_t)row * DM + c;
#pragma unroll
                        for (int e = 0; e < 4; ++e) atomicAdd(o + e, v[e]);
                    }
            }
    }
};
struct EpiBin {
    static constexpr bool PERM = true, AFTER_DRAIN = false, NORMAL = false;
    const float* ssq1; bf16_t* XM; bf16_t* SZ; float* out;
    DI void operator()(const f32x4 (&acc)[2][2][4][2], const Unit& u, int wr, int wc, int fr, int fq) const {
        const bool isz = u.pn >= 8; const int col0 = (u.pn & 7) * 256 + wc * 32 + 8 * fq; const size_t zoff = isz ? (size_t)((WS_SZ - WS_XM) / 2) : (size_t)0;
#pragma unroll
        for (int ai = 0; ai < 2; ++ai)
#pragma unroll
            for (int m = 0; m < 4; ++m) {
                const int row = u.pm * 256 + ai * 128 + wr * 64 + m * 16 + fr;
                const float rs = rsqrtf(ssq1[row] * (1.f / DM) + 1e-6f);
                float* dst = nullptr;
                if (!isz) {
                    if (row < TP) { const int t = row & 2047; if (t >= 2045) dst = out + O_CBP + (size_t)((row >> 11) * 3 + (t - 2045)) * WD; }
                    else { const int t = row & 7; if (t >= 5) dst = out + O_CBS + (size_t)(((row - TP) >> 3) * 3 + (t - 5)) * WD; }
                }
#pragma unroll
                for (int bj = 0; bj < 2; ++bj) {
                    f32x4 v0 = acc[ai][bj][m][0] * rs, v1 = acc[ai][bj][m][1] * rs; const int c = col0 + bj * 128;
                    if (isz) {
#pragma unroll
                        for (int e = 0; e < 4; ++e) { v0[e] = silu_f(v0[e]); v1[e] = silu_f(v1[e]); }
                    } else if (dst) { *(f32x4*)(dst + c) = v0; *(f32x4*)(dst + c + 4) = v1; }
                    u32x4 w; w.x = cvt_pk_bf16(v0[0], v0[1]); w.y = cvt_pk_bf16(v0[2], v0[3]); w.z = cvt_pk_bf16(v1[0], v1[1]); w.w = cvt_pk_bf16(v1[2], v1[3]);
                    *(u32x4*)(XM + zoff + (size_t)row * WD + c) = w;
                }
            }
    }
};
struct EpiQ {
    static constexpr bool PERM = true, AFTER_DRAIN = false, NORMAL = false;
    bf16_t* Q; float* gates;
    DI void operator()(const f32x4 (&acc)[2][2][4][2], const Unit& u, int wr, int wc, int fr, int fq) const {
        if (u.pn == 8) {
            if (wc == 0 && fq == 0) {
#pragma unroll
                for (int ai = 0; ai < 2; ++ai)
#pragma unroll
                    for (int m = 0; m < 4; ++m) { float* gp = gates + (size_t)(u.pm * 256 + ai * 128 + wr * 64 + m * 16 + fr) * 8;
#pragma unroll
                        for (int e = 0; e < 4; ++e) { atomicAdd(gp + e, acc[ai][0][m][0][e]); atomicAdd(gp + 4 + e, acc[ai][0][m][1][e]); } }
            }
            return;
        }
        const int col0 = u.pn * 256 + wc * 32 + 8 * fq;
#pragma unroll
        for (int ai = 0; ai < 2; ++ai)
#pragma unroll
            for (int m = 0; m < 4; ++m) {
                const int row = u.pm * 256 + ai * 128 + wr * 64 + m * 16 + fr;
#pragma unroll
                for (int bj = 0; bj < 2; ++bj) {
                    const f32x4 v0 = acc[ai][bj][m][0], v1 = acc[ai][bj][m][1];
                    u32x4 w; w.x = cvt_pk_bf16(v0[0], v0[1]); w.y = cvt_pk_bf16(v0[2], v0[3]); w.z = cvt_pk_bf16(v1[0], v1[1]); w.w = cvt_pk_bf16(v1[2], v1[3]);
                    *(u32x4*)(Q + (size_t)row * WD + col0 + bj * 128) = w;
                }
            }
    }
};
struct EpiKV {
    static constexpr bool PERM = false, AFTER_DRAIN = false, NORMAL = true;
    bf16_t* XT; bf16_t* XR; float* gates;
    DI void operator()(const f32x4 (&acc)[2][2][4][2], const Unit& u, int wr, int wc, int fr, int fq) const {
        if (u.pn == 8) {
            if (wc == 0 && fr < 8) {
#pragma unroll
                for (int ai = 0; ai < 2; ++ai)
#pragma unroll
                    for (int m = 0; m < 4; ++m) { float* gp = gates + (size_t)(u.pm * 256 + ai * 128 + wr * 64 + m * 16 + 4 * fq) * 8 + fr;
#pragma unroll
                        for (int j = 0; j < 4; ++j) atomicAdd(gp + 8 * j, acc[ai][0][m][0][j]); }
            }
            return;
        }
#pragma unroll
        for (int ai = 0; ai < 2; ++ai)
#pragma unroll
            for (int m = 0; m < 4; ++m) {
                const int row0 = u.pm * 256 + ai * 128 + wr * 64 + m * 16 + 4 * fq;
#pragma unroll
                for (int bj = 0; bj < 2; ++bj)
#pragma unroll
                    for (int n = 0; n < 2; ++n) {
                        const int col = u.pn * 256 + bj * 128 + wc * 32 + n * 16 + fr; const f32x4 v = acc[ai][bj][m][n];
                        u32x2 w; w.x = cvt_pk_bf16(v[0], v[1]); w.y = cvt_pk_bf16(v[2], v[3]);
                        *(u32x2*)(XT + ((size_t)(row0 >> 2) * WD + col) * 4) = w;
                        if (XR) {
                            XR[(size_t)(row0 + 0) * WD + col] = (bf16_t)(w.x & 0xffffu); XR[(size_t)(row0 + 1) * WD + col] = (bf16_t)(w.x >> 16);
                            XR[(size_t)(row0 + 2) * WD + col] = (bf16_t)(w.y & 0xffffu); XR[(size_t)(row0 + 3) * WD + col] = (bf16_t)(w.y >> 16);
                        }
                    }
            }
    }
};

template <int MODE>
DI void p0_transpose_item(const float* W, int K, int N, bf16_t* WT, const float* kscale, LAS float* scr, int item, int lane) {
    const int nblk = N / 32, kb = item / nblk, nb = item % nblk, k0 = 64 * kb, n0 = 32 * nb;
#pragma unroll 32
    for (int i = 0; i < 32; ++i) { const int kk = 2 * i + (lane >> 5); float v = W[(size_t)(k0 + kk) * N + n0 + (lane & 31)]; if (kscale) v *= kscale[k0 + kk]; scr[kk * 33 + (lane & 31)] = v; }
    asm volatile("s_waitcnt lgkmcnt(0)" ::: "memory");
    const int c = lane & 7;
#pragma unroll
    for (int j = 0; j < 4; ++j) { const int n = (lane >> 3) + 8 * j; const LAS float* s = scr + (8 * c) * 33 + n;
        u32x4 o; o.x = pk2(s[0 * 33], s[1 * 33]); o.y = pk2(s[2 * 33], s[3 * 33]); o.z = pk2(s[4 * 33], s[5 * 33]); o.w = pk2(s[6 * 33], s[7 * 33]);
        int src = n0 + n, dest = src;
        if (MODE == 1) { const int type = src >> 11, pn = (src & 2047) >> 6, ch = src & 63; dest = 256 * pn + 128 * (type >> 1) + 16 * (type & 1) + 32 * (ch >> 4) + (ch & 15); }
        *(u32x4*)(WT + (size_t)dest * K + k0 + 8 * c) = o; }
    asm volatile("s_waitcnt lgkmcnt(0)" ::: "memory");
}
DI void phase0(const Params& p, LAS unsigned char* lds, int G, const int wv__) {
    const int tid = ltid(), lane = tid & 63, wave = tid >> 6;
    unsigned char* ws = p.ws;
    LAS float* scr = (LAS float*)(lds + wave * 16384);
    const int gw = blockIdx.x * 8 + wave, NGW = G * 8;
    { float* z = (float*)(ws + WS_ZERO); for (size_t i = (size_t)blockIdx.x * 512 + tid; i < Z_END; i += (size_t)G * 512) z[i] = 0.f; }
    constexpr int I0 = 16 * 256, I1 = 32 * 32, I2 = 16 * 128, I3 = 32 * 64, I4 = 32 * 32, NIT = I0 + I1 + I2 + 3 * I3 + I4;
    for (int it = gw; it < NIT; it += NGW) {
        int r = it;
        if (r < I0) { p0_transpose_item<1>(p.a_w_in, 1024, 8192, (bf16_t*)(ws + WS_WAIN), nullptr, scr, r, lane); continue; } r -= I0;
        if (r < I1) { p0_transpose_item<0>(p.a_w_out, 2048, 1024, (bf16_t*)(ws + WS_WAOUT), nullptr, scr, r, lane); continue; } r -= I1;
        if (r < I2) { p0_transpose_item<0>(p.b_w_in, 1024, 4096, (bf16_t*)(ws + WS_WBIN), p.norm_w + DM, scr, r, lane); continue; } r -= I2;
        if (r < I3) { p0_transpose_item<0>(p.b_w_q, 2048, 2048, (bf16_t*)(ws + WS_WQ), nullptr, scr, r, lane); continue; } r -= I3;
        if (r < I3) { p0_transpose_item<0>(p.b_w_k, 2048, 2048, (bf16_t*)(ws + WS_WK), nullptr, scr, r, lane); continue; } r -= I3;
        if (r < I3) { p0_transpose_item<0>(p.b_w_v, 2048, 2048, (bf16_t*)(ws + WS_WV), nullptr, scr, r, lane); continue; } r -= I3;
        p0_transpose_item<0>(p.b_w_out, 2048, 1024, (bf16_t*)(ws + WS_WBOUT), nullptr, scr, r, lane);
    }
    {
        f32x4 nw[4];
#pragma unroll
        for (int j = 0; j < 4; ++j) nw[j] = *(const f32x4*)(p.norm_w + 4 * lane + 256 * j);
        for (int row = gw; row < TT; row += 2 * NGW) {
            const int row2 = (row + NGW < TT) ? row + NGW : row;
            const float* xa = row < TP ? p.x_prompt + (size_t)row * DM : p.x_sample + (size_t)(row - TP) * DM;
            const float* xb = row2 < TP ? p.x_prompt + (size_t)row2 * DM : p.x_sample + (size_t)(row2 - TP) * DM;
            f32x4 va[4], vb[4]; float sa = 0.f, sb = 0.f;
#pragma unroll
            for (int j = 0; j < 4; ++j) { va[j] = *(const f32x4*)(xa + 4 * lane + 256 * j); vb[j] = *(const f32x4*)(xb + 4 * lane + 256 * j); }
#pragma unroll
            for (int j = 0; j < 4; ++j) { sa += (va[j][0] * va[j][0] + va[j][1] * va[j][1]) + (va[j][2] * va[j][2] + va[j][3] * va[j][3]); sb += (vb[j][0] * vb[j][0] + vb[j][1] * vb[j][1]) + (vb[j][2] * vb[j][2] + vb[j][3] * vb[j][3]); }
            const float ra = rsqrtf(wave_sum(sa) * (1.f / DM) + 1e-6f), rb = rsqrtf(wave_sum(sb) * (1.f / DM) + 1e-6f);
            bf16_t* oa = (bf16_t*)(ws + WS_XN0) + (size_t)row * DM; bf16_t* ob = (bf16_t*)(ws + WS_XN0) + (size_t)row2 * DM;
#pragma unroll
            for (int j = 0; j < 4; ++j) {
                u32x2 pa; pa.x = pk2(va[j][0] * ra * nw[j][0], va[j][1] * ra * nw[j][1]); pa.y = pk2(va[j][2] * ra * nw[j][2], va[j][3] * ra * nw[j][3]);
                u32x2 pb; pb.x = pk2(vb[j][0] * rb * nw[j][0], vb[j][1] * rb * nw[j][1]); pb.y = pk2(vb[j][2] * rb * nw[j][2], vb[j][3] * rb * nw[j][3]);
                *(u32x2*)(oa + 4 * lane + 256 * j) = pa; *(u32x2*)(ob + 4 * lane + 256 * j) = pb; }
        }
    }
    for (int task = gw; task < 2 * 2048; task += NGW) {
        const int set = task / 2048, ch = task % 2048;
        float a[8];
#pragma unroll
        for (int g = 0; g < 8; ++g) a[g] = 0.f;
        for (int mm = 0; mm < 2; ++mm) {
            if (set == 1 && mm == 1) break;
            const int mat = set == 1 ? 2 : mm;
            const float* W = (mat == 0 ? p.b_w_q : (mat == 1 ? p.b_w_k : p.b_w_v)) + (size_t)ch * 2048;
            const float* wif = p.b_w_if + (size_t)mat * 2048 * 8;
#pragma unroll 8
            for (int i = 0; i < 32; ++i) { const int n = lane + 64 * i; const float w = W[n]; const f32x4 f0 = *(const f32x4*)(wif + (size_t)n * 8), f1 = *(const f32x4*)(wif + (size_t)n * 8 + 4);
#pragma unroll
                for (int g = 0; g < 4; ++g) { a[g] += w * f0[g]; a[4 + g] += w * f1[g]; } }
        }
#pragma unroll
        for (int g = 0; g < 8; ++g) a[g] = wave_sum(a[g]);
        if (lane == 0) {
            bf16_t* bt = (bf16_t*)(ws + (set == 0 ? WS_WQ : WS_WV));
#pragma unroll
            for (int g = 0; g < 8; ++g) bt[(size_t)(2048 + g) * 2048 + ch] = (bf16_t)f2bf(a[g]);
        }
    }
    for (size_t i = (size_t)blockIdx.x * 512 + tid; i < (size_t)2 * 63488; i += (size_t)G * 512) {
        const size_t j = i % 63488; u32x4* z = (u32x4*)(ws + (i < 63488 ? WS_WQ : WS_WV) + (size_t)2056 * 2048 * 2) + j; *z = (u32x4){0u, 0u, 0u, 0u}; }
}

DI void phase_convB(const Params& p, int G, bool do_gates, const int wv__) {
    const bf16_t* XM = (const bf16_t*)(p.ws + WS_XM); bf16_t* XC = (bf16_t*)(p.ws + WS_XC);
    const float* WG = (const float*)(p.ws + WS_WG); float* gates = (float*)(p.ws + WS_ZERO) + Z_GATES;
    const int lane = ltid() & 63;
    const int ntask = (TT / 8) * 512;
    for (int task = blockIdx.x * 512 + ltid(); task < ntask; task += G * 512) {
        const int cg4 = task & 511, rb = task >> 9, row0 = rb * 8, ch = cg4 * 4;
        float cw[4][4], cb[4], p3[4], p2[4], p1[4]; f32x4 wg0[4][2], wg1[4][2];
#pragma unroll
        for (int e = 0; e < 4; ++e) { cb[e] = p.b_conv_b[ch + e];
#pragma unroll
            for (int j = 0; j < 4; ++j) cw[j][e] = p.b_conv_w[j * WD + ch + e];
            wg0[e][0] = *(const f32x4*)(WG + (size_t)(ch + e) * 8); wg0[e][1] = *(const f32x4*)(WG + (size_t)(ch + e) * 8 + 4);
            wg1[e][0] = *(const f32x4*)(WG + (size_t)(2048 + ch + e) * 8); wg1[e][1] = *(const f32x4*)(WG + (size_t)(2048 + ch + e) * 8 + 4); }
        if (row0 >= TP) { const int b = (row0 - TP) >> 3;
#pragma unroll
            for (int e = 0; e < 4; ++e) { p3[e] = p.st_conv_b[(size_t)(b * 3 + 0) * WD + ch + e]; p2[e] = p.st_conv_b[(size_t)(b * 3 + 1) * WD + ch + e]; p1[e] = p.st_conv_b[(size_t)(b * 3 + 2) * WD + ch + e]; } }
        else if ((row0 & 2047) == 0) {
#pragma unroll
            for (int e = 0; e < 4; ++e) { p3[e] = 0.f; p2[e] = 0.f; p1[e] = 0.f; } }
        else { unpack4(*(const u32x2*)(XM + (size_t)(row0 - 3) * WD + ch), p3); unpack4(*(const u32x2*)(XM + (size_t)(row0 - 2) * WD + ch), p2); unpack4(*(const u32x2*)(XM + (size_t)(row0 - 1) * WD + ch), p1); }
        float gv[64];
#pragma unroll
        for (int r = 0; r < 8; ++r) {
            float xm[4], xc[4];
            unpack4(*(const u32x2*)(XM + (size_t)(row0 + r) * WD + ch), xm);
            f32x4 g0 = {0.f, 0.f, 0.f, 0.f}, g1 = {0.f, 0.f, 0.f, 0.f};
#pragma unroll
            for (int e = 0; e < 4; ++e) { xc[e] = silu_f(cb[e] + cw[0][e] * p3[e] + cw[1][e] * p2[e] + cw[2][e] * p1[e] + cw[3][e] * xm[e]); p3[e] = p2[e]; p2[e] = p1[e]; p1[e] = xm[e];
                if (do_gates) { g0 += wg0[e][0] * xc[e] + wg1[e][0] * xm[e]; g1 += wg0[e][1] * xc[e] + wg1[e][1] * xm[e]; } }
            u32x2 o; o.x = pk2(xc[0], xc[1]); o.y = pk2(xc[2], xc[3]);
            *(u32x2*)(XC + (size_t)(row0 + r) * WD + ch) = o;
#pragma unroll
            for (int g = 0; g < 4; ++g) { gv[r * 8 + g] = g0[g]; gv[r * 8 + 4 + g] = g1[g]; }
        }
#pragma unroll
        for (int m = 32, n = 64; do_gates && m >= 1; m >>= 1, n >>= 1) {
            const bool up = (lane & m) != 0;
#pragma unroll
            for (int i = 0; i < 32; ++i) if (i < n / 2) {
                const float keep = up ? gv[i + n / 2] : gv[i], send = up ? gv[i] : gv[i + n / 2];
                gv[i] = keep + __shfl_xor(send, m);
            }
        }
        if (do_gates) atomicAdd(gates + (size_t)(row0 + (lane >> 3)) * 8 + (lane & 7), gv[0]);
    }
}

DI void phase_sraw(const Params& p, int G, const int wv__) {
    const bf16_t* Q = (const bf16_t*)(p.ws + WS_Q); const bf16_t* KR = (const bf16_t*)(p.ws + WS_KR); float* SR = (float*)(p.ws + WS_SRAW);
    const int lane = ltid() & 63, w = ltid() >> 6, r = lane & 15, q4 = lane >> 4;
    for (int item = blockIdx.x; item < 1024; item += G) {
        const int bh = item >> 5, c = item & 31, b = bh >> 2, h = bh & 3, T0 = b * 2048 + 64 * c, F0 = 512 * h;
        const int it = w >> 1;
        if (w == 0) {
            const float* gates = (const float*)(p.ws + WS_ZERO) + Z_GATES;
            const float gi = gates[(size_t)(T0 + lane) * 8 + h] + p.b_b_if[h], gf = gates[(size_t)(T0 + lane) * 8 + 4 + h] + p.b_b_if[4 + h];
            float bc = log_sigmoid_f(gf);
#pragma unroll
            for (int o = 1; o < 64; o <<= 1) { const float t = __shfl_up(bc, o); if (lane >= o) bc += t; }
            const float a = gi - bc; float cm = a;
#pragma unroll
            for (int o = 1; o < 64; o <<= 1) { const float t = __shfl_up(cm, o); if (lane >= o) cm = fmaxf(cm, t); }
            *(f32x4*)(p.ws + WS_SC + ((size_t)item * 64 + lane) * 16) = (f32x4){bc, a, cm, 0.f};
        }
        f32x4 acc[2] = {{0.f, 0.f, 0.f, 0.f}, {0.f, 0.f, 0.f, 0.f}};
        const bf16_t* qa = Q + (size_t)(T0 + 16 * it + r) * WD + F0 + 8 * q4;
        const bf16_t* kb0 = KR + (size_t)(T0 + 16 * ((w & 1) * 2 + 0) + r) * WD + F0 + 8 * q4;
        const bf16_t* kb1 = KR + (size_t)(T0 + 16 * ((w & 1) * 2 + 1) + r) * WD + F0 + 8 * q4;
#pragma unroll 8
        for (int ks = 0; ks < 16; ++ks) {
            const bf16x8 a = *(const bf16x8*)(qa + 32 * ks), b0 = *(const bf16x8*)(kb0 + 32 * ks), b1 = *(const bf16x8*)(kb1 + 32 * ks);
            acc[0] = __builtin_amdgcn_mfma_f32_16x16x32_bf16(a, b0, acc[0], 0, 0, 0);
            acc[1] = __builtin_amdgcn_mfma_f32_16x16x32_bf16(a, b1, acc[1], 0, 0, 0);
        }
#pragma unroll
        for (int d = 0; d < 2; ++d) { const int jt = (w & 1) * 2 + d;
#pragma unroll
            for (int j = 0; j < 4; ++j) SR[((size_t)item * 64 + 16 * it + 4 * q4 + j) * 64 + 16 * jt + r] = acc[d][j]; }
    }
}

DI bf16x8 pack8(f32x4 a, f32x4 b) { u32x4 v; v.x = cvt_pk_bf16(a[0], a[1]); v.y = cvt_pk_bf16(a[2], a[3]); v.z = cvt_pk_bf16(b[0], b[1]); v.w = cvt_pk_bf16(b[2], b[3]); return __builtin_bit_cast(bf16x8, v); }
DI bf16x8 join8(u32x2 a, u32x2 b) { u32x4 v; v.x = a.x; v.y = a.y; v.z = b.x; v.w = b.y; return __builtin_bit_cast(bf16x8, v); }

DI void mlstm_prompt_item(const Params& p, LAS unsigned char* lds, int item, bool stats, const int wv__) {
    const int tid = ltid(), lane = tid & 63, w = tid >> 6, r = lane & 15, q4 = lane >> 4;
    const int bh = item >> 3, s = item & 7, b = bh >> 2, h = bh & 3;
    const bf16_t* Q = (const bf16_t*)(p.ws + WS_Q); const bf16_t* KT = (const bf16_t*)(p.ws + WS_KT); const bf16_t* VT = (const bf16_t*)(p.ws + WS_VT);
    const float* SR = (const float*)(p.ws + WS_SRAW); const float* gates = (const float*)(p.ws + WS_ZERO) + Z_GATES;
    bf16_t* H = (bf16_t*)(p.ws + WS_H); float* hst = (float*)(p.ws + WS_ZERO) + Z_HST;
    LAS f32x4* red = (LAS f32x4*)lds;
    LAS float* qnred = (LAS float*)(lds + 131072);
    LAS float* nbuf = (LAS float*)(lds + 131072 + 2048);
    LAS float* sc = (LAS float*)(lds + 131072 + 4096 + w * 1536);
    LAS float* s_a = sc, *s_M = sc + 64, *s_wg = sc + 128, *s_wi = sc + 192, *s_ei = sc + 256, *s_rs = sc + 320;
    const int D0 = 64 * w, F0 = 512 * h, V0 = 512 * h + 64 * s;
    const unsigned om = (w & 1) ? 0xffffffffu : 0u; const int it_o = w >> 1;
    f32x4 C[4][4];
#pragma unroll
    for (int i = 0; i < 4; ++i)
#pragma unroll
        for (int j = 0; j < 4; ++j) C[i][j] = (f32x4){0.f, 0.f, 0.f, 0.f};
    const unsigned qlane = (unsigned)(r * WD + F0 + D0 + 4 * q4) * 2u, klane = (unsigned)(2 * q4 * WD + F0 + D0 + r) * 8u, vlane = (unsigned)(2 * q4 * WD + V0 + r) * 8u;
    float mst = 0.f;
    nbuf[tid] = 0.f;
    __syncthreads();
    unsigned pfoff;
    {
        const size_t Tb = (size_t)b * 2048;
        size_t o;
        if (tid < 64) o = WS_Q + ((Tb + 8 * s + (tid >> 3)) * WD + F0 + 64 * (tid & 7)) * 2;
        else if (tid < 128) o = WS_KT + ((Tb / 4 + 2 * s + ((tid - 64) >> 5)) * WD + F0) * 8 + 128 * ((tid - 64) & 31);
        else if (tid < 192) o = WS_VT + ((Tb / 4 + ((tid - 128) >> 2)) * WD + V0) * 8 + 128 * ((tid - 128) & 3);
        else { o = WS_SRAW + ((size_t)bh * 32 * 4096) * 4 + 128 * (16 * s + ((tid - 192) & 15)); }
        pfoff = (unsigned)o;
    }
    const f32x4* SC = (const f32x4*)(p.ws + WS_SC) + (size_t)bh * 32 * 64 + lane;
    f32x4 sc_n = SC[0];
    for (int c = 0; c < 32; ++c) {
        const int T0 = b * 2048 + 64 * c;
        u32x2 qa[4][2][2], ka[4][2][2], va[4][2][2];
        {
            int T0s = T0; asm volatile("" : "+s"(T0s));
            const char* qb = (const char*)Q + (size_t)T0s * (WD * 2);
            const char* kb = (const char*)KT + (size_t)(T0s >> 2) * (WD * 8);
            const char* vb = (const char*)VT + (size_t)(T0s >> 2) * (WD * 8);
#pragma unroll
            for (int ks = 0; ks < 2; ++ks) {
#pragma unroll
                for (int it = 0; it < 4; ++it) {
                    qa[it][ks][0] = *(const u32x2*)(qb + (size_t)(it * 16 * WD * 2 + ks * 64) + qlane); qa[it][ks][1] = *(const u32x2*)(qb + (size_t)(it * 16 * WD * 2 + ks * 64 + 32) + qlane); }
            }
#pragma unroll
            for (int ks = 0; ks < 2; ++ks) {
#pragma unroll
                for (int t4 = 0; t4 < 4; ++t4) {
                    ka[t4][ks][0] = *(const u32x2*)(kb + (size_t)((8 * ks * WD + 16 * t4) * 8) + klane); ka[t4][ks][1] = *(const u32x2*)(kb + (size_t)(((8 * ks + 1) * WD + 16 * t4) * 8) + klane);
                    va[t4][ks][0] = *(const u32x2*)(vb + (size_t)((8 * ks * WD + 16 * t4) * 8) + vlane); va[t4][ks][1] = *(const u32x2*)(vb + (size_t)(((8 * ks + 1) * WD + 16 * t4) * 8) + vlane);
                }
            }
        }
        float decay, m_next;
        {
            const float bc = sc_n[0], a = sc_n[1], cm = sc_n[2];
            sc_n = SC[(size_t)(c < 31 ? c + 1 : c) * 64];
            const float gsum = __shfl(bc, 63), amax = __shfl(cm, 63);
            const float Mi = fmaxf(mst, cm), M63 = fmaxf(mst, amax);
            decay = __expf(mst - M63); m_next = gsum + M63;
            s_a[lane] = a; s_M[lane] = Mi; s_wg[lane] = QK_SCALE * __expf(a - M63); s_wi[lane] = __expf(mst - Mi); s_ei[lane] = __expf(-(bc + Mi));
        }
        asm volatile("s_waitcnt lgkmcnt(0)" ::: "memory");
        {
#pragma unroll
            for (int it = 0; it < 4; ++it) {
                f32x4 P[4];
#pragma unroll
                for (int j = 0; j < 4; ++j) P[j] = (f32x4){0.f, 0.f, 0.f, 0.f};
                float qnp = 0.f;
#pragma unroll
                for (int ks = 0; ks < 2; ++ks) {
                    float ql[4], qh[4]; unpack4(qa[it][ks][0], ql); unpack4(qa[it][ks][1], qh);
                    const f32x4 nl = *(const LAS f32x4*)(nbuf + D0 + 32 * ks + 4 * q4), nh = *(const LAS f32x4*)(nbuf + D0 + 32 * ks + 16 + 4 * q4);
                    qnp += (ql[0] * nl[0] + ql[1] * nl[1]) + (ql[2] * nl[2] + ql[3] * nl[3]) + (qh[0] * nh[0] + qh[1] * nh[1]) + (qh[2] * nh[2] + qh[3] * nh[3]);
                    const bf16x8 qf = join8(qa[it][ks][0], qa[it][ks][1]);
#pragma unroll
                    for (int dvt = 0; dvt < 4; ++dvt) { const bf16x8 cf = pack8(C[2 * ks][dvt], C[2 * ks + 1][dvt]); P[dvt] = __builtin_amdgcn_mfma_f32_16x16x32_bf16(qf, cf, P[dvt], 0, 0, 0); }
                }
#pragma unroll
                for (int dvt = 0; dvt < 4; ++dvt) red[(w * 16 + it * 4 + dvt) * 64 + lane] = P[dvt];
                qnp += __shfl_xor(qnp, 16); qnp += __shfl_xor(qnp, 32);
                if (q4 == 0) qnred[w * 64 + 16 * it + r] = qnp;
            }
        }
        {
#pragma unroll
            for (int dkt = 0; dkt < 4; ++dkt)
#pragma unroll
                for (int dvt = 0; dvt < 4; ++dvt) C[dkt][dvt] *= decay;
            float npart[4] = {0.f, 0.f, 0.f, 0.f};
#pragma unroll
            for (int ks = 0; ks < 2; ++ks) {
                bf16x8 vw[4];
                const f32x4 wl = *(const LAS f32x4*)(s_wg + 32 * ks + 8 * q4), wh = *(const LAS f32x4*)(s_wg + 32 * ks + 8 * q4 + 4);
#pragma unroll
                for (int dvt = 0; dvt < 4; ++dvt) {
                    float vl[4], vh[4]; unpack4(va[dvt][ks][0], vl); unpack4(va[dvt][ks][1], vh);
                    f32x4 a = {vl[0] * wl[0], vl[1] * wl[1], vl[2] * wl[2], vl[3] * wl[3]}, bb = {vh[0] * wh[0], vh[1] * wh[1], vh[2] * wh[2], vh[3] * wh[3]};
                    vw[dvt] = pack8(a, bb);
                }
#pragma unroll
                for (int dkt = 0; dkt < 4; ++dkt) {
                    float kl[4], kh[4]; unpack4(ka[dkt][ks][0], kl); unpack4(ka[dkt][ks][1], kh);
                    npart[dkt] += (kl[0] * wl[0] + kl[1] * wl[1]) + (kl[2] * wl[2] + kl[3] * wl[3]) + (kh[0] * wh[0] + kh[1] * wh[1]) + (kh[2] * wh[2] + kh[3] * wh[3]);
                    const bf16x8 kf = join8(ka[dkt][ks][0], ka[dkt][ks][1]);
#pragma unroll
                    for (int dvt = 0; dvt < 4; ++dvt) C[dkt][dvt] = __builtin_amdgcn_mfma_f32_16x16x32_bf16(kf, vw[dvt], C[dkt][dvt], 0, 0, 0);
                }
            }
#pragma unroll
            for (int dkt = 0; dkt < 4; ++dkt) { float v = npart[dkt]; v += __shfl_xor(v, 16); v += __shfl_xor(v, 32);
                if (q4 == 0) nbuf[D0 + 16 * dkt + r] = decay * nbuf[D0 + 16 * dkt + r] + v; }
        }
        unsigned pfv = 0u;
        if (c < 31 && tid < 208) pfv = *(const unsigned*)(p.ws + (size_t)(pfoff + (unsigned)(c + 1) * (tid < 192 ? 262144u : 16384u)));
        f32x4 sr[2][2];
#pragma unroll
        for (int ks = 0; ks < 2; ++ks) { const unsigned so = (unsigned)(((bh * 32 + c) * 64 + 16 * it_o + r) * 64 + 32 * ks + 8 * q4) * 4u;
            sr[ks][0] = *(const f32x4*)((const char*)SR + so); sr[ks][1] = *(const f32x4*)((const char*)SR + so + 16u); }
        __syncthreads();
        {
            const int it = it_o;
            f32x4 acc2[2], sv[2] = {{0.f, 0.f, 0.f, 0.f}, {0.f, 0.f, 0.f, 0.f}};
#pragma unroll
            for (int d2 = 0; d2 < 2; ++d2) { const int tile = it * 4 + 2 * (w & 1) + d2; f32x4 a = red[tile * 64 + lane];
#pragma unroll 3
                for (int ww = 1; ww < 8; ++ww) a += red[(ww * 16 + tile) * 64 + lane];
                acc2[d2] = a; }
            float qn[4];
#pragma unroll
            for (int j = 0; j < 4; ++j) { float a = 0.f;
#pragma unroll
                for (int ww = 0; ww < 8; ++ww) a += qnred[ww * 64 + 16 * it + 4 * q4 + j];
                qn[j] = a; }
            const int i = 16 * it + r; const float Mi = s_M[i]; float rowsum = 0.f;
#pragma unroll
            for (int ks = 0; ks < 2; ++ks) {
                const f32x4 s0 = sr[ks][0], s1 = sr[ks][1];
                const f32x4 a0 = *(const LAS f32x4*)(s_a + 32 * ks + 8 * q4), a1 = *(const LAS f32x4*)(s_a + 32 * ks + 8 * q4 + 4);
                f32x4 e0, e1;
#pragma unroll
                for (int j = 0; j < 4; ++j) { const int j0 = 32 * ks + 8 * q4 + j;
                    e0[j] = (j0 <= i) ? s0[j] * QK_SCALE * __expf(a0[j] - Mi) : 0.f; e1[j] = (j0 + 4 <= i) ? s1[j] * QK_SCALE * __expf(a1[j] - Mi) : 0.f;
                    rowsum += e0[j] + e1[j]; }
                const bf16x8 sf = pack8(e0, e1);
#pragma unroll
                for (int d2 = 0; d2 < 2; ++d2) {
                    const u32x2 x0 = (va[d2][ks][0] & ~om) | (va[2 + d2][ks][0] & om), x1 = (va[d2][ks][1] & ~om) | (va[2 + d2][ks][1] & om);
                    sv[d2] = __builtin_amdgcn_mfma_f32_16x16x32_bf16(sf, join8(x0, x1), sv[d2], 0, 0, 0); }
            }
            rowsum += __shfl_xor(rowsum, 16); rowsum += __shfl_xor(rowsum, 32);
            if (q4 == 0) s_rs[r] = rowsum;
            asm volatile("s_waitcnt lgkmcnt(0)" ::: "memory");
            float s1[4] = {0.f, 0.f, 0.f, 0.f}, s2[4] = {0.f, 0.f, 0.f, 0.f};
#pragma unroll
            for (int j = 0; j < 4; ++j) {
                const int ii = 16 * it + 4 * q4 + j; const float wi = s_wi[ii];
                const float den = wi * qn[j] + s_rs[4 * q4 + j]; const float dn = fmaxf(fabsf(den), s_ei[ii]); const float inv = 1.f / dn;
#pragma unroll
                for (int d2 = 0; d2 < 2; ++d2) { const int dvt = 2 * (w & 1) + d2; const float hv = (wi * acc2[d2][j] + sv[d2][j]) * inv;
                    H[(size_t)(T0 + ii) * WD + V0 + 16 * dvt + r] = (bf16_t)f2bf(hv); s1[j] += hv; s2[j] += hv * hv; }
            }
#pragma unroll
            for (int j = 0; j < 4; ++j) {
#pragma unroll
                for (int o = 1; o < 16; o <<= 1) { s1[j] += __shfl_xor(s1[j], o); s2[j] += __shfl_xor(s2[j], o); }
                if (r == 0 && stats) { const int ii = 16 * it + 4 * q4 + j; atomicAdd(hst + ((size_t)(T0 + ii) * 4 + h) * 2, s1[j]); atomicAdd(hst + ((size_t)(T0 + ii) * 4 + h) * 2 + 1, s2[j]); }
            }
        }
        mst = m_next;
        if (pfv == 0x9e3779b9u) ((unsigned*)(p.ws + WS_BAR))[3600] = pfv;
        __syncthreads();
    }
#pragma unroll
    for (int dkt = 0; dkt < 4; ++dkt)
#pragma unroll
        for (int dvt = 0; dvt < 4; ++dvt)
#pragma unroll
            for (int j = 0; j < 4; ++j) p.out[O_CP + ((size_t)bh * 512 + D0 + 16 * dkt + 4 * q4 + j) * 512 + 64 * s + 16 * dvt + r] = C[dkt][dvt][j];
    if (s == 0) { p.out[O_NP + (size_t)bh * 512 + tid] = nbuf[tid]; if (tid == 0) p.out[O_MP + bh] = mst; }
    __syncthreads();
}

DI void mlstm_sample_item(const Params& p, LAS unsigned char* lds, int item, bool stats, const int wv__) {
    const int tid = ltid(), lane = tid & 63, w = tid >> 6;
    int zv = 0; asm volatile("" : "+v"(zv));
    const int bh = item, b = bh >> 2, h = bh & 3, R0 = TP + 8 * b + zv, F0 = 512 * h;
    const bf16_t* Q = (const bf16_t*)(p.ws + WS_Q); const bf16_t* KR = (const bf16_t*)(p.ws + WS_KR); const bf16_t* VT = (const bf16_t*)(p.ws + WS_VT);
    const float* gates = (const float*)(p.ws + WS_ZERO) + Z_GATES; bf16_t* H = (bf16_t*)(p.ws + WS_H); float* hst = (float*)(p.ws + WS_ZERO) + Z_HST;
    LAS float* qs = (LAS float*)lds;
    LAS float* kws = (LAS float*)(lds + 16384);
    LAS float* red = (LAS float*)(lds + 32768);
    LAS float* Sred = (LAS float*)(lds + 98304);
    LAS float* Sm = (LAS float*)(lds + 98304 + 2048);
    LAS float* qnw = (LAS float*)(lds + 98304 + 2304);
    LAS float* hs = (LAS float*)(lds + 98304 + 2560);
    const float m0 = p.st_m[bh + zv];
    float av[8], Mv[8], wi[8], wg[8], ei[8]; float bc = 0.f, cm = -INFINITY;
#pragma unroll
    for (int t = 0; t < 8; ++t) { const float gi = gates[(size_t)(R0 + t) * 8 + h + zv] + p.b_b_if[h + zv], gf = gates[(size_t)(R0 + t) * 8 + 4 + h + zv] + p.b_b_if[4 + h + zv];
        bc += log_sigmoid_f(gf); av[t] = gi - bc; cm = fmaxf(cm, av[t]); Mv[t] = fmaxf(m0, cm); wi[t] = __expf(m0 - Mv[t]); ei[t] = __expf(-(bc + Mv[t])); }
    const float M7 = Mv[7], decay = __expf(m0 - M7), m_new = bc + M7;
#pragma unroll
    for (int t = 0; t < 8; ++t) wg[t] = QK_SCALE * __expf(av[t] - M7);
    { const int i = lane >> 3, jj = lane & 7; const bf16_t* qp = Q + (size_t)(R0 + i) * WD + F0 + 64 * w; const bf16_t* kp = KR + (size_t)(R0 + jj) * WD + F0 + 64 * w; float a = 0.f;
#pragma unroll
        for (int k8 = 0; k8 < 8; ++k8) { float qf[8], kf[8]; unpack8(*(const u32x4*)(qp + 8 * k8), qf); unpack8(*(const u32x4*)(kp + 8 * k8), kf);
#pragma unroll
            for (int e = 0; e < 8; ++e) a += qf[e] * kf[e]; }
        Sred[w * 64 + lane] = a; }
    { const float n0 = p.st_n[(size_t)bh * 512 + tid]; float qv[8], kv[8], ksum = 0.f;
#pragma unroll
        for (int t = 0; t < 8; ++t) { qv[t] = wi[t] * bflo((unsigned)Q[(size_t)(R0 + t) * WD + F0 + tid]); kv[t] = wg[t] * bflo((unsigned)KR[(size_t)(R0 + t) * WD + F0 + tid]); ksum += kv[t]; }
        *(LAS f32x4*)(qs + tid * 8) = (f32x4){qv[0], qv[1], qv[2], qv[3]}; *(LAS f32x4*)(qs + tid * 8 + 4) = (f32x4){qv[4], qv[5], qv[6], qv[7]};
        *(LAS f32x4*)(kws + tid * 8) = (f32x4){kv[0], kv[1], kv[2], kv[3]}; *(LAS f32x4*)(kws + tid * 8 + 4) = (f32x4){kv[4], kv[5], kv[6], kv[7]};
        p.out[O_NS + (size_t)bh * 512 + tid] = decay * n0 + ksum;
#pragma unroll
        for (int t = 0; t < 8; ++t) { const float v = wave_sum(qv[t] * n0); if (lane == 0) qnw[w * 8 + t] = v; } }
    __syncthreads();
    if (tid < 64) { const int i = tid >> 3, jj = tid & 7; float a = 0.f;
#pragma unroll
        for (int ww = 0; ww < 8; ++ww) a += Sred[ww * 64 + tid];
        float avj = av[0], Mi = Mv[0];
#pragma unroll
        for (int t = 1; t < 8; ++t) { if (jj == t) avj = av[t]; if (i == t) Mi = Mv[t]; }
        Sm[tid] = (jj <= i) ? a * QK_SCALE * __expf(avj - Mi) : 0.f; }
    __syncthreads();
    const int dg = tid >> 7, ec = tid & 127, e0 = 4 * ec;
    f32x4 v[8];
#pragma unroll
    for (int tq = 0; tq < 2; ++tq) {
        float vv[4][4];
#pragma unroll
        for (int e = 0; e < 4; ++e) unpack4(*(const u32x2*)(VT + ((size_t)(R0 / 4 + tq) * WD + F0 + e0 + e) * 4), vv[e]);
#pragma unroll
        for (int j = 0; j < 4; ++j) v[4 * tq + j] = (f32x4){vv[0][j], vv[1][j], vv[2][j], vv[3][j]};
    }
    f32x4 num[8];
#pragma unroll
    for (int i = 0; i < 8; ++i) num[i] = (f32x4){0.f, 0.f, 0.f, 0.f};
    const float* C0 = p.st_C + ((size_t)bh * 512) * 512 + e0; float* C1 = p.out + O_CS + ((size_t)bh * 512) * 512 + e0;
#pragma unroll 8
    for (int it = 0; it < 128; ++it) {
        const int d = dg + 4 * it;
        const f32x4 c4 = __builtin_nontemporal_load((const f32x4*)(C0 + (size_t)d * 512));
        const f32x4 q0 = *(const LAS f32x4*)(qs + d * 8), q1 = *(const LAS f32x4*)(qs + d * 8 + 4), k0 = *(const LAS f32x4*)(kws + d * 8), k1 = *(const LAS f32x4*)(kws + d * 8 + 4);
        f32x4 cn = c4 * decay;
#pragma unroll
        for (int i = 0; i < 4; ++i) { num[i] += c4 * q0[i]; num[4 + i] += c4 * q1[i]; cn += v[i] * k0[i]; cn += v[4 + i] * k1[i]; }
        __builtin_nontemporal_store(cn, (f32x4*)(C1 + (size_t)d * 512));
    }
#pragma unroll
    for (int i = 0; i < 8; ++i) *(LAS f32x4*)(red + (dg * 8 + i) * 512 + 4 * ec) = num[i];
    __syncthreads();
    float vc[8];
    { float t0[4], t1[4]; unpack4(*(const u32x2*)(VT + ((size_t)(R0 / 4) * WD + F0 + tid) * 4), t0); unpack4(*(const u32x2*)(VT + ((size_t)(R0 / 4 + 1) * WD + F0 + tid) * 4), t1);
#pragma unroll
      for (int j = 0; j < 4; ++j) { vc[j] = t0[j]; vc[4 + j] = t1[j]; } }
#pragma unroll
    for (int i = 0; i < 8; ++i) {
        float a = (red[(0 * 8 + i) * 512 + tid] + red[(1 * 8 + i) * 512 + tid]) + (red[(2 * 8 + i) * 512 + tid] + red[(3 * 8 + i) * 512 + tid]);
#pragma unroll
        for (int j = 0; j < 8; ++j) a += Sm[i * 8 + j] * vc[j];
        float den = 0.f;
#pragma unroll
        for (int j = 0; j < 8; ++j) den += Sm[i * 8 + j] + qnw[j * 8 + i];
        const float hv = a / fmaxf(fabsf(den), ei[i]);
        H[(size_t)(R0 + i) * WD + F0 + tid] = (bf16_t)f2bf(hv);
        const float s1 = wave_sum(hv), s2 = wave_sum(hv * hv);
        if (lane == 0 && stats) { atomicAdd(hst + ((size_t)(R0 + i) * 4 + h) * 2, s1); atomicAdd(hst + ((size_t)(R0 + i) * 4 + h) * 2 + 1, s2); }
    }
    if (tid == 0) p.out[O_MS + bh] = m_new;
    __syncthreads();
}

DI void outprep_load(const bf16_t* H, const float* hst, const bf16_t* XC, const bf16_t* SZ, int task, float& mu, float& rs, f32x4& h0, f32x4& h1, u32x4& xc, u32x4& sz) {
    const int cg8 = task & 255, row = task >> 8, ch = cg8 * 8, head = ch >> 9;
    mu = hst[((size_t)row * 4 + head) * 2] * (1.f / 512.f); const float var = fmaxf(hst[((size_t)row * 4 + head) * 2 + 1] * (1.f / 512.f) - mu * mu, 0.f);
    rs = rsqrtf(var + 1e-5f);
    { float hf[8]; unpack8(*(const u32x4*)(H + (size_t)row * WD + ch), hf); h0 = (f32x4){hf[0], hf[1], hf[2], hf[3]}; h1 = (f32x4){hf[4], hf[5], hf[6], hf[7]}; }
    xc = *(const u32x4*)(XC + (size_t)row * WD + ch); sz = *(const u32x4*)(SZ + (size_t)row * WD + ch);
}
DI void outprep_store(bf16_t* OB, int task, float mu, float rs, f32x4 h0, f32x4 h1, u32x4 xcp, u32x4 szp, f32x4 o0, f32x4 o1, f32x4 k0, f32x4 k1) {
    const int cg8 = task & 255, row = task >> 8, ch = cg8 * 8;
    float xc[8], sz[8], y[8]; unpack8(xcp, xc); unpack8(szp, sz);
#pragma unroll
    for (int e = 0; e < 4; ++e) { y[e] = ((h0[e] - mu) * rs * o0[e] + k0[e] * xc[e]) * sz[e]; y[4 + e] = ((h1[e] - mu) * rs * o1[e] + k1[e] * xc[4 + e]) * sz[4 + e]; }
    u32x4 o; o.x = pk2(y[0], y[1]); o.y = pk2(y[2], y[3]); o.z = pk2(y[4], y[5]); o.w = pk2(y[6], y[7]);
    *(u32x4*)(OB + (size_t)row * WD + ch) = o;
}
DI void phase_outprep(const Params& p, int G, const int wv__) {
    const bf16_t* H = (const bf16_t*)(p.ws + WS_H); const float* hst = (const float*)(p.ws + WS_ZERO) + Z_HST;
    const bf16_t* XC = (const bf16_t*)(p.ws + WS_XC); const bf16_t* SZ = (const bf16_t*)(p.ws + WS_SZ); bf16_t* OB = (bf16_t*)(p.ws + WS_OB);
    const int ntask = TT * 256, NT = G * 512;
    const int t0 = blockIdx.x * 512 + ltid(), ch = (t0 & 255) * 8;
    const f32x4 o0 = *(const f32x4*)(p.b_onorm_w + ch), o1 = *(const f32x4*)(p.b_onorm_w + ch + 4), k0 = *(const f32x4*)(p.b_skip + ch), k1 = *(const f32x4*)(p.b_skip + ch + 4);
    for (int task = t0; task < ntask; task += 2 * NT) {
        const int task2 = task + NT; const bool has2 = task2 < ntask;
        float muA, rsA, muB, rsB; f32x4 hA0, hA1, hB0, hB1; u32x4 xA, zA, xB, zB;
        outprep_load(H, hst, XC, SZ, task, muA, rsA, hA0, hA1, xA, zA);
        outprep_load(H, hst, XC, SZ, has2 ? task2 : task, muB, rsB, hB0, hB1, xB, zB);
        outprep_store(OB, task, muA, rsA, hA0, hA1, xA, zA, o0, o1, k0, k1);
        if (has2) outprep_store(OB, task2, muB, rsB, hB0, hB1, xB, zB, o0, o1, k0, k1);
    }
}
DI void phase_final(const Params& p, int G, const int wv__) {
    const int lane = ltid() & 63, gw = blockIdx.x * 8 + (ltid() >> 6), NGW = G * 8;
    f32x4 fw[4];
#pragma unroll
    for (int j = 0; j < 4; ++j) fw[j] = *(const f32x4*)(p.final_norm_w + 4 * lane + 256 * j);
    for (int row = gw; row < TT; row += 2 * NGW) {
        const int row2 = row + NGW; const bool has2 = row2 < TT;
        float* y0 = p.out + O_Y + (size_t)row * DM; float* y1 = p.out + O_Y + (size_t)(has2 ? row2 : row) * DM;
        f32x4 v0[4], v1[4]; float s0 = 0.f, s1 = 0.f;
#pragma unroll
        for (int j = 0; j < 4; ++j) { v0[j] = *(const f32x4*)(y0 + 4 * lane + 256 * j); v1[j] = *(const f32x4*)(y1 + 4 * lane + 256 * j); }
#pragma unroll
        for (int j = 0; j < 4; ++j) { s0 += (v0[j][0] * v0[j][0] + v0[j][1] * v0[j][1]) + (v0[j][2] * v0[j][2] + v0[j][3] * v0[j][3]); s1 += (v1[j][0] * v1[j][0] + v1[j][1] * v1[j][1]) + (v1[j][2] * v1[j][2] + v1[j][3] * v1[j][3]); }
        const float r0 = rsqrtf(wave_sum(s0) * (1.f / DM) + 1e-6f), r1 = rsqrtf(wave_sum(s1) * (1.f / DM) + 1e-6f);
#pragma unroll
        for (int j = 0; j < 4; ++j) { *(f32x4*)(y0 + 4 * lane + 256 * j) = v0[j] * r0 * fw[j]; if (has2) *(f32x4*)(y1 + 4 * lane + 256 * j) = v1[j] * r1 * fw[j]; }
    }
}

#define XB_TMO      128
#define XB_XCNT(j)  (256  + 64 * (j))
#define XB_XSUB(j)  (1280 + 64 * (j))
#define XB_XGEN(j)  (2304 + 64 * (j))
#define XB_TOP      3328
#define XB_TOPGEN   3392
#define XCD_BAR_WORDS 3456
#define XB_SPIN_CAP (1u << 18)
DI unsigned xb_ld(unsigned* p)              { return __hip_atomic_load(p, __ATOMIC_RELAXED, __HIP_MEMORY_SCOPE_AGENT); }
DI unsigned xb_add(unsigned* p, unsigned v) { return __hip_atomic_fetch_add(p, v, __ATOMIC_RELAXED, __HIP_MEMORY_SCOPE_AGENT); }
DI unsigned xb_xcc_id() { return (unsigned)__builtin_amdgcn_s_getreg((3 << 11) | 20) & 0xFu; }
#define XB_SPIN(cond, bar) do { unsigned _sp = 0; while (cond) { __builtin_amdgcn_s_sleep(1); \
    if ((++_sp & 255u) == 0u) { if (xb_ld(&(bar)[XB_TMO])) break; if (_sp > XB_SPIN_CAP) { atomicAdd(&(bar)[XB_TMO], 1u); break; } } } } while (0)
DI void xcd_barrier_complete(unsigned* bar, unsigned x, unsigned& nloc, unsigned& nx) {
    const unsigned G = gridDim.x;
    unsigned sum, cnt, mine, sp = 0u;
    for (;;) {
        sum = 0u; cnt = 0u; mine = 0u;
#pragma unroll
        for (unsigned j = 0; j < 16; ++j) { const unsigned c = xb_ld(&bar[XB_XCNT(j)]); sum += c; cnt += (c > 0u) ? 1u : 0u; mine = (j == x) ? c : mine; }
        if (sum == G) break;
        __builtin_amdgcn_s_sleep(1);
        if ((++sp & 255u) == 0u) { if (xb_ld(&bar[XB_TMO])) break; if (sp > XB_SPIN_CAP) { atomicAdd(&bar[XB_TMO], 1u); break; } }
    }
    nloc = mine > 0u ? mine : 1u; nx = cnt > 0u ? cnt : 1u;
}
DI void xcd_barrier(unsigned* bar, volatile LAS unsigned* st, const int wv__) {
    asm volatile("s_waitcnt vmcnt(0)" ::: "memory");
    __syncthreads();
    if (ltid() == 0) {
        const unsigned x = xb_xcc_id();
        __builtin_amdgcn_s_waitcnt(0);
        unsigned nloc = st[0], nx = st[1];
        if (nloc == 0u) { xcd_barrier_complete(bar, x, nloc, nx); st[0] = nloc; st[1] = nx; }
        const unsigned old = xb_add(&bar[XB_XSUB(x)], 1u);
        const unsigned gen = old / nloc;
        if (old + 1u == (gen + 1u) * nloc) {
            __builtin_amdgcn_fence(__ATOMIC_RELEASE, "agent");
            asm volatile("s_waitcnt vmcnt(0)" ::: "memory");
            const unsigned og = xb_add(&bar[XB_TOP], 1u);
            const unsigned tg = og / nx;
            if (og + 1u == (tg + 1u) * nx) xb_add(&bar[XB_TOPGEN], 1u);
            else XB_SPIN(xb_ld(&bar[XB_TOPGEN]) == tg, bar);
            __builtin_amdgcn_fence(__ATOMIC_ACQUIRE, "agent");
            xb_add(&bar[XB_XGEN(x)], 1u);
            asm volatile("s_waitcnt vmcnt(0)" ::: "memory");
        } else {
            XB_SPIN(xb_ld(&bar[XB_XGEN(x)]) == gen, bar);
            __builtin_amdgcn_fence(__ATOMIC_ACQUIRE, "agent");
            asm volatile("s_waitcnt vmcnt(0)" ::: "memory");
        }
    }
    __syncthreads();
}

DI Params load_params() {
    const __attribute__((address_space(4))) unsigned long long* k = (const __attribute__((address_space(4))) unsigned long long*)__builtin_amdgcn_kernarg_segment_ptr();
    asm volatile("" : "+s"(k));
    Params p; unsigned long long* d = (unsigned long long*)&p;
#pragma unroll
    for (int i = 0; i < 25; ++i) d[i] = k[i];
    return p;
}
__global__ void __launch_bounds__(512, 2) fwd_megakernel(Params p_unused) {
    extern __shared__ __attribute__((aligned(16))) unsigned char lds_raw[];
    LAS unsigned char* lds = (LAS unsigned char*)lds_raw;
    cg::grid_group grid = cg::this_grid();
    const int G = gridDim.x, bx = blockIdx.x;
    const int wv__ = __builtin_amdgcn_readfirstlane((int)threadIdx.x >> 6);
    volatile LAS unsigned* bst = (volatile LAS unsigned*)(lds + LDS_BYTES - 64);
    if (ltid() == 0) { bst[0] = 0u; bst[1] = 0u; }
    __syncthreads();

    if (ltid() == 0) (void)xb_add((unsigned*)(load_params().ws + WS_BAR) + XB_XCNT(xb_xcc_id()), 1u);
    { const Params p = load_params(); phase0(p, lds, G, wv__); }
    if (G > 65535) grid.sync();
    xcd_barrier((unsigned*)(load_params().ws + WS_BAR), bst, wv__);
    {
        const Params p = load_params(); unsigned char* ws = p.ws;
        pg8::Gemm g{(const bf16_t*)(ws + WS_XN0), (const bf16_t*)(ws + WS_WAIN), TT, 8192, 1024}; pg8::StaticOrder S; S.init(TT, 8192, G, bx);
        EpiAin E{(bf16_t*)(ws + WS_U), (bf16_t*)(ws + WS_GZ), (bf16_t*)(ws + WS_YA), p.out, p.a_conv_w, p.st_conv_a};
        pg8::gemm_phase<EpiAin, pg8::StaticOrder, true, true>(lds, g, S, E, wv__);
    }
    xcd_barrier((unsigned*)(load_params().ws + WS_BAR), bst, wv__);
    {
        const Params p = load_params(); unsigned char* ws = p.ws; float* zf = (float*)(ws + WS_ZERO);
        pg8::Gemm g{(const bf16_t*)(ws + WS_YA), (const bf16_t*)(ws + WS_WAOUT), TT, 1024, 2048}; pg8::StaticOrder S; S.init(TT, 1024, G, bx);
        { Unit uu; for (int i = 0; S.next(i, uu); ++i) convA_fixup_panel(p, uu.pm, wv__); }
        asm volatile("s_waitcnt vmcnt(0)" ::: "memory"); __syncthreads();
        EpiRes E{p.x_prompt, p.x_sample, TP, (float*)(ws + WS_X1), (bf16_t*)(ws + WS_X1B), zf + Z_SSQ1};
        pg8::gemm_phase<EpiRes, pg8::StaticOrder, true, true>(lds, g, S, E, wv__);
    }
    xcd_barrier((unsigned*)(load_params().ws + WS_BAR), bst, wv__);
    {
        const Params p = load_params(); unsigned char* ws = p.ws; float* zf = (float*)(ws + WS_ZERO);
        pg8::Gemm g{(const bf16_t*)(ws + WS_X1B), (const bf16_t*)(ws + WS_WBIN), TT, 4096, 1024}; pg8::StaticOrder S; S.init(TT, 4096, G, bx);
        EpiBin E{zf + Z_SSQ1, (bf16_t*)(ws + WS_XM), (bf16_t*)(ws + WS_SZ), p.out};
        pg8::gemm_phase<EpiBin, pg8::StaticOrder, true, true>(lds, g, S, E, wv__);
    }
    xcd_barrier((unsigned*)(load_params().ws + WS_BAR), bst, wv__);
    { const Params p = load_params(); phase_convB(p, G, false, wv__); }
    xcd_barrier((unsigned*)(load_params().ws + WS_BAR), bst, wv__);
    {
        const Params p = load_params(); unsigned char* ws = p.ws; float* gates = (float*)(ws + WS_ZERO) + Z_GATES;
        pg8::StaticOrder Sq, Sk, Sv; Sq.init(TT, 2304, G, bx); Sk.init(TT, 2048, G, (bx + G - 104) % G); Sv.init(TT, 2304, G, (bx + G - 136) % G);
        { pg8::Gemm g{(const bf16_t*)(ws + WS_XC), (const bf16_t*)(ws + WS_WQ), TT, 2304, 2048};
          EpiQ E{(bf16_t*)(ws + WS_Q), gates}; pg8::gemm_phase<EpiQ, pg8::StaticOrder, true, true>(lds, g, Sq, E, wv__); }
        { pg8::Gemm g{(const bf16_t*)(ws + WS_XC), (const bf16_t*)(ws + WS_WK), TT, 2048, 2048};
          EpiKV E{(bf16_t*)(ws + WS_KT), (bf16_t*)(ws + WS_KR), nullptr}; pg8::gemm_phase<EpiKV, pg8::StaticOrder, true, true>(lds, g, Sk, E, wv__); }
        { pg8::Gemm g{(const bf16_t*)(ws + WS_XM), (const bf16_t*)(ws + WS_WV), TT, 2304, 2048};
          EpiKV E{(bf16_t*)(ws + WS_VT), nullptr, gates}; pg8::gemm_phase<EpiKV, pg8::StaticOrder, true, true>(lds, g, Sv, E, wv__); }
    }
    xcd_barrier((unsigned*)(load_params().ws + WS_BAR), bst, wv__);
    { const Params p = load_params(); phase_sraw(p, G, wv__); }
    xcd_barrier((unsigned*)(load_params().ws + WS_BAR), bst, wv__);
    {
        const bool sample_first = (G == 256) && bx < 128;
        if (sample_first) { const Params p = load_params(); for (int item = bx; item < 512; item += G) mlstm_sample_item(p, lds, item, true, wv__); }
        { const Params p = load_params();
          for (int i = bx; i < 256; i += G) { const int item = (G == 256) ? (((i & 7) * 4 + (i >> 6)) * 8 + ((i >> 3) & 7)) : i; mlstm_prompt_item(p, lds, item, true, wv__); } }
        if (!sample_first) { const Params p = load_params(); for (int item = bx; item < 512; item += G) mlstm_sample_item(p, lds, item, true, wv__); }
    }
    xcd_barrier((unsigned*)(load_params().ws + WS_BAR), bst, wv__);
    { const Params p = load_params(); phase_outprep(p, G, wv__); }
    xcd_barrier((unsigned*)(load_params().ws + WS_BAR), bst, wv__);
    {
        const Params p = load_params(); unsigned char* ws = p.ws; float* zf = (float*)(ws + WS_ZERO);
        {
            pg8::Gemm g{(const bf16_t*)(ws + WS_OB), (const bf16_t*)(ws + WS_WBOUT), TT, 1024, 2048}; pg8::StaticOrder S; S.init(TT, 1024, G, bx);
            EpiRes E{(const float*)(ws + WS_X1), (const float*)(ws + WS_X1), TT, p.out + O_Y, nullptr, nullptr};
            pg8::gemm_phase<EpiRes, pg8::StaticOrder, true, true>(lds, g, S, E, wv__);
        }
    }
    xcd_barrier((unsigned*)(load_params().ws + WS_BAR), bst, wv__);
    { const Params p = load_params(); phase_final(p, G, wv__); }
}

extern "C" void kernel_launch(void* const* d_in, const int* in_sizes, int n_in, void* d_out, int out_size, void* d_ws, size_t ws_size, hipStream_t stream) {
    static int grid = 0;
    if (grid == 0) {
        if (n_in != 23 || ws_size < WS_END) { fprintf(stderr, "kernel_launch: unexpected n_in %d / ws %zu (need %zu)\n", n_in, ws_size, (size_t)WS_END); grid = -1; return; }
        int dev = 0, cus = 0, per_cu = 0;
        (void)hipGetDevice(&dev);
        (void)hipDeviceGetAttribute(&cus, hipDeviceAttributeMultiprocessorCount, dev);
        (void)hipFuncSetAttribute((const void*)fwd_megakernel, hipFuncAttributeMaxDynamicSharedMemorySize, LDS_BYTES);
        (void)hipOccupancyMaxActiveBlocksPerMultiprocessor(&per_cu, (const void*)fwd_megakernel, 512, LDS_BYTES);
        if (per_cu < 1) { fprintf(stderr, "kernel_launch: occupancy query says %d blocks/CU\n", per_cu); }
        grid = cus;
    }
    if (grid < 0) return;
    Params p{};
    const float** pp = (const float**)&p;
    for (int i = 0; i < 23; ++i) pp[i] = (const float*)d_in[i];
    p.out = (float*)d_out; p.ws = (unsigned char*)d_ws;
    void* args[] = {&p};
    (void)hipMemsetAsync((char*)d_ws + WS_BAR, 0, 16384, stream);
    hipError_t e = hipLaunchCooperativeKernel((void*)fwd_megakernel, dim3(grid), dim3(512), args, LDS_BYTES, stream);
    if (e != hipSuccess) fprintf(stderr, "cooperative launch failed: %s (grid %d)\n", hipGetErrorString(e), grid);
}
```
